# Optimizing an MI355X kernel written in HIP

```python
import math
import jax, jax.numpy as jnp
from jax import lax
import numpy as np


D_MODEL = 2048
BATCH = 2
SEQ = 4096
DEPTH = 1

D_SSD = D_MODEL // 2
SSD_HEAD_DIM = 64
SSD_HEADS = D_SSD // SSD_HEAD_DIM
SSD_GROUPS = 4
D_STATE = 128
CONV_WIDTH = 4
CHUNK = 128
D_CONV = D_SSD + 2 * SSD_GROUPS * D_STATE
D_POOL = D_MODEL - D_SSD
POOL_WINDOWS = (2, 4, 8, 16)
POOL_GROUPS = len(POOL_WINDOWS)
POOL_GROUP_DIM = D_POOL // POOL_GROUPS
D_MIX = D_SSD + D_POOL
D_IN_PROJ = D_SSD + D_CONV + SSD_HEADS + D_POOL
N_MEM = 256
XATTN_HEADS = 4
XATTN_HEAD_DIM = D_MODEL // XATTN_HEADS
N_EXPERTS = 32
TOP_K = 4
D_FF = D_MODEL
SWIGLU_LIMIT = 7.0
SWIGLU_ALPHA = 1.702
MOE_BLOCK = 128
EPS = 1e-5

kernel_name = 'hybrid_ssd_pool_xattn_moe_layer'


def _rmsnorm(x, w):
    x32 = x.astype(jnp.float32)
    y = x32 * lax.rsqrt(jnp.mean(x32 * x32, axis=-1, keepdims=True) + EPS)
    return (y * w.astype(jnp.float32)).astype(x.dtype)


def _ssd_chunked(xh, dt, a, bm, cm):
    b, s = xh.shape[:2]
    c = s // CHUNK
    r = SSD_HEADS // SSD_GROUPS
    dtype = xh.dtype
    xr = (xh * dt[..., None].astype(dtype)).reshape(b, c, CHUNK, SSD_GROUPS, r, SSD_HEAD_DIM)
    a_cs = jnp.cumsum((dt * a).reshape(b, c, CHUNK, SSD_GROUPS, r), axis=2)
    br = bm.reshape(b, c, CHUNK, SSD_GROUPS, D_STATE)
    cr = cm.reshape(b, c, CHUNK, SSD_GROUPS, D_STATE)
    causal = jnp.tril(jnp.ones((CHUNK, CHUNK), dtype=bool))[None, None, :, :, None, None]
    seg = a_cs[:, :, :, None] - a_cs[:, :, None, :]
    decay_ls = jnp.exp(jnp.where(causal, seg, -jnp.inf)).astype(dtype)
    cb = jnp.einsum('bclgn,bcsgn->bclsg', cr, br)
    y_diag = jnp.einsum('bclsg,bclsgr,bcsgrp->bclgrp', cb, decay_ls, xr)
    decay_to_end = jnp.exp(a_cs[:, :, -1:] - a_cs).astype(dtype)
    states = jnp.einsum('bclgn,bclgr,bclgrp->bcgrpn', br, decay_to_end, xr)
    chunk_decay = jnp.exp(a_cs[:, :, -1]).astype(dtype)

    def step(h, inp):
        st, dec = inp
        return h * dec[..., None, None] + st, h

    h0 = jnp.zeros((b, SSD_GROUPS, r, SSD_HEAD_DIM, D_STATE), dtype)
    _, prev = lax.scan(step, h0, (jnp.moveaxis(states, 1, 0), jnp.moveaxis(chunk_decay, 1, 0)))
    prev = jnp.moveaxis(prev, 0, 1)
    y_off = jnp.einsum('bclgn,bcgrpn,bclgr->bclgrp', cr, prev, jnp.exp(a_cs).astype(dtype))
    return (y_diag + y_off).reshape(b, s, SSD_HEADS, SSD_HEAD_DIM)


def _pool_mixer(u, pool_w, pool_scale):
    b, s, _ = u.shape
    pos_count = jnp.arange(1, s + 1, dtype=jnp.float32)[None, :, None]
    outs = []
    for g, w in enumerate(POOL_WINDOWS):
        ug = u[..., g * POOL_GROUP_DIM:(g + 1) * POOL_GROUP_DIM].astype(jnp.float32)
        csp = jnp.concatenate([jnp.zeros_like(ug[:, :1]), jnp.cumsum(ug, axis=1)], axis=1)
        lo = jnp.concatenate([jnp.zeros_like(ug[:, :w - 1]), csp[:, :s - w + 1]], axis=1)
        mean = (csp[:, 1:] - lo) / jnp.minimum(pos_count, float(w))
        outs.append(mean - ug)
    pooled = jnp.stack(outs, axis=2).astype(u.dtype)
    mixed = jnp.einsum('bsgc,gcd->bsgd', pooled, pool_w)
    return mixed.reshape(b, s, D_POOL) * pool_scale


def _mixer(hn, w_in, conv_w, conv_b, dt_bias, a_log, d_skip, ssd_norm, pool_w, pool_scale, w_out):
    b, s, _ = hn.shape
    proj = hn @ w_in
    z, xbc, dt_raw, u = jnp.split(proj, [D_SSD, D_SSD + D_CONV, D_SSD + D_CONV + SSD_HEADS], axis=-1)
    xbc = lax.conv_general_dilated(xbc, conv_w[:, None, :], (1,), [(CONV_WIDTH - 1, 0)],
                                   dimension_numbers=('NWC', 'WIO', 'NWC'),
                                   feature_group_count=D_CONV)
    xbc = jax.nn.silu(xbc + conv_b)
    xs, bs, cs = jnp.split(xbc, [D_SSD, D_SSD + SSD_GROUPS * D_STATE], axis=-1)
    dt = jax.nn.softplus(dt_raw.astype(jnp.float32) + dt_bias.astype(jnp.float32))
    a = -jnp.exp(a_log.astype(jnp.float32))
    xh = xs.reshape(b, s, SSD_HEADS, SSD_HEAD_DIM)
    y = _ssd_chunked(xh, dt, a, bs.reshape(b, s, SSD_GROUPS, D_STATE), cs.reshape(b, s, SSD_GROUPS, D_STATE))
    y = y + d_skip[:, None] * xh
    y = (y.reshape(b, s, D_SSD) * jax.nn.silu(z)).reshape(b, s, SSD_GROUPS, D_SSD // SSD_GROUPS)
    y = _rmsnorm(y, ssd_norm.reshape(SSD_GROUPS, D_SSD // SSD_GROUPS)).reshape(b, s, D_SSD)
    yp = _pool_mixer(u, pool_w, pool_scale)
    return jnp.concatenate([y, yp], axis=-1) @ w_out


def _cross_attn(hn, mem_n, w_q, w_kv, w_o):
    b, s, _ = hn.shape
    q = (hn @ w_q).reshape(b, s, XATTN_HEADS, XATTN_HEAD_DIM)
    k, v = jnp.split(mem_n @ w_kv, 2, axis=-1)
    k = k.reshape(b, -1, XATTN_HEADS, XATTN_HEAD_DIM)
    v = v.reshape(b, -1, XATTN_HEADS, XATTN_HEAD_DIM)
    scores = jnp.einsum('bshd,bmhd->bhsm', q.astype(jnp.float32), k.astype(jnp.float32)) * (XATTN_HEAD_DIM ** -0.5)
    p = jax.nn.softmax(scores, axis=-1).astype(v.dtype)
    o = jnp.einsum('bhsm,bmhd->bshd', p, v).reshape(b, s, D_MODEL)
    return o @ w_o


def _moe(hn, w_router, b_router, w_gate, b_gate, w_up, b_up, w_down, b_down):
    b, s, d = hn.shape
    t = b * s
    xf = hn.reshape(t, d)
    logits = (xf @ w_router + b_router).astype(jnp.float32)
    top_val, top_idx = lax.top_k(logits, TOP_K)
    gates = jax.nn.softmax(top_val, axis=-1).astype(hn.dtype)
    tk = t * TOP_K
    n_blocks = (tk + N_EXPERTS * (MOE_BLOCK - 1) + MOE_BLOCK - 1) // MOE_BLOCK
    n_rows = n_blocks * MOE_BLOCK
    flat_e = top_idx.reshape(tk).astype(jnp.int32)
    flat_tok = jnp.arange(tk, dtype=jnp.int32) // TOP_K
    flat_g = gates.reshape(tk)
    order = jnp.argsort(flat_e, stable=True)
    sorted_e = flat_e[order]
    counts = jnp.bincount(flat_e, length=N_EXPERTS).astype(jnp.int32)
    padded = (counts + MOE_BLOCK - 1) // MOE_BLOCK * MOE_BLOCK
    start = jnp.cumsum(counts) - counts
    padded_end = jnp.cumsum(padded)
    padded_start = padded_end - padded
    dest = padded_start[sorted_e] + jnp.arange(tk, dtype=jnp.int32) - start[sorted_e]
    row_tok = jnp.full((n_rows,), t, jnp.int32).at[dest].set(flat_tok[order])
    row_gate = jnp.zeros((n_rows,), hn.dtype).at[dest].set(flat_g[order])
    block_e = jnp.clip(jnp.searchsorted(padded_end, jnp.arange(n_blocks, dtype=jnp.int32) * MOE_BLOCK,
                                        side='right'), 0, N_EXPERTS - 1)
    x_pad = jnp.concatenate([xf, jnp.zeros((1, d), xf.dtype)], axis=0)
    rows = x_pad[row_tok].reshape(n_blocks, MOE_BLOCK, d)

    def expert_block(args):
        xb, e = args
        g = xb @ w_gate[e] + b_gate[e]
        u = xb @ w_up[e] + b_up[e]
        g = jnp.minimum(g, SWIGLU_LIMIT)
        u = jnp.clip(u, -SWIGLU_LIMIT, SWIGLU_LIMIT)
        act = g * jax.nn.sigmoid(SWIGLU_ALPHA * g) * (u + 1.0)
        return act @ w_down[e] + b_down[e]

    y = lax.map(expert_block, (rows, block_e)).reshape(n_rows, d)
    out = jnp.zeros((t + 1, d), y.dtype).at[row_tok].add(y * row_gate[:, None])
    return out[:t].reshape(b, s, d)


def setup_inputs(seed: int = 0) -> dict:
    key = jax.random.key(seed)
    ks = jax.random.split(key, 32)
    f32 = jnp.float32
    L = DEPTH

    def w(k, shape, fan_in):
        return jax.random.normal(k, shape, f32) * (fan_in ** -0.5)

    def gain(k, shape):
        return 1.0 + 0.05 * jax.random.normal(k, shape, f32)

    def small(k, shape):
        return 0.01 * jax.random.normal(k, shape, f32)

    dt0 = jnp.exp(jax.random.uniform(ks[5], (L, SSD_HEADS), f32, math.log(1e-3), math.log(1e-1)))
    return {
        'x': jax.random.normal(ks[0], (BATCH, SEQ, D_MODEL), f32),
        'mem': jax.random.normal(ks[1], (BATCH, N_MEM, D_MODEL), f32),
        'norm_mix': gain(ks[2], (L, D_MODEL)),
        'w_in': w(ks[3], (L, D_MODEL, D_IN_PROJ), D_MODEL),
        'conv_w': w(ks[4], (L, CONV_WIDTH, D_CONV), CONV_WIDTH),
        'conv_b': small(ks[6], (L, D_CONV)),
        'dt_bias': dt0 + jnp.log(-jnp.expm1(-dt0)),
        'a_log': jnp.log(jax.random.uniform(ks[7], (L, SSD_HEADS), f32, 1.0, 16.0)),
        'd_skip': gain(ks[8], (L, SSD_HEADS)),
        'ssd_norm': gain(ks[9], (L, D_SSD)),
        'pool_w': w(ks[10], (L, POOL_GROUPS, POOL_GROUP_DIM, POOL_GROUP_DIM), POOL_GROUP_DIM),
        'pool_scale': 1.0 + 0.1 * jax.random.normal(ks[11], (L, D_POOL), f32),
        'w_out': w(ks[12], (L, D_MIX, D_MODEL), D_MIX),
        'norm_xattn': gain(ks[13], (L, D_MODEL)),
        'norm_mem': gain(ks[14], (L, D_MODEL)),
        'w_q': w(ks[15], (L, D_MODEL, D_MODEL), D_MODEL),
        'w_kv': w(ks[16], (L, D_MODEL, 2 * D_MODEL), D_MODEL),
        'w_o': w(ks[17], (L, D_MODEL, D_MODEL), D_MODEL),
        'norm_ffn': gain(ks[18], (L, D_MODEL)),
        'w_router': w(ks[19], (L, D_MODEL, N_EXPERTS), D_MODEL),
        'b_router': small(ks[20], (L, N_EXPERTS)),
        'w_gate': w(ks[21], (L, N_EXPERTS, D_MODEL, D_FF), D_MODEL),
        'b_gate': small(ks[22], (L, N_EXPERTS, D_FF)),
        'w_up': w(ks[23], (L, N_EXPERTS, D_MODEL, D_FF), D_MODEL),
        'b_up': small(ks[24], (L, N_EXPERTS, D_FF)),
        'w_down': w(ks[25], (L, N_EXPERTS, D_FF, D_MODEL), D_FF),
        'b_down': small(ks[26], (L, N_EXPERTS, D_MODEL)),
        'norm_final': gain(ks[27], (D_MODEL,)),
    }


def reference(x, mem, norm_mix, w_in, conv_w, conv_b, dt_bias, a_log, d_skip, ssd_norm, pool_w,
              pool_scale, w_out, norm_xattn, norm_mem, w_q, w_kv, w_o, norm_ffn, w_router, b_router,
              w_gate, b_gate, w_up, b_up, w_down, b_down, norm_final):
    h = x
    for l in range(DEPTH):
        h = h + _mixer(_rmsnorm(h, norm_mix[l]), w_in[l], conv_w[l], conv_b[l], dt_bias[l], a_log[l],
                       d_skip[l], ssd_norm[l], pool_w[l], pool_scale[l], w_out[l])
        h = h + _cross_attn(_rmsnorm(h, norm_xattn[l]), _rmsnorm(mem, norm_mem[l]), w_q[l], w_kv[l], w_o[l])
        h = h + _moe(_rmsnorm(h, norm_ffn[l]), w_router[l], b_router[l], w_gate[l], b_gate[l],
                     w_up[l], b_up[l], w_down[l], b_down[l])
    return _rmsnorm(h, norm_final)
```

```cpp
#include <hip/hip_runtime.h>
#include <cstdio>
#include <cstdint>

#ifndef MK_LAUNCHES
#define MK_LAUNCHES 14
#endif

#define GAS __attribute__((address_space(1)))
#define LAS __attribute__((address_space(3)))
typedef unsigned short bf16;
typedef short bf16x8 __attribute__((ext_vector_type(8)));
typedef float f32x4 __attribute__((ext_vector_type(4)));
typedef float f32x2 __attribute__((ext_vector_type(2)));
typedef unsigned u32x4 __attribute__((ext_vector_type(4)));
typedef unsigned u32x2 __attribute__((ext_vector_type(2)));

constexpr int NB = 2, SEQ = 4096, T = NB * SEQ, D = 2048;
constexpr int DSSD = 1024, HEADS = 16, HD = 64, GROUPS = 4, NST = 128, CHUNK = 128, NCH = SEQ / CHUNK;
constexpr int DIN = 4112, PCOLS = 4096;
constexpr int DCONV = 2048;
constexpr int NMEM = 256, XH = 4, XHD = 512;
constexpr int NE = 32, TOPK = 4;
constexpr int SLOT_CAP = 41216;
constexpr float EPS = 1e-5f;
constexpr int NTHREADS = 512, NWAVES = 8;
constexpr int NPHASE = 14;

constexpr size_t MiB = 1u << 20;
constexpr size_t WS_CTL = 0, CTL_ZERO_BYTES = 1 * MiB;
constexpr size_t WS_WIN = 1 * MiB;
constexpr size_t WS_WOUT = WS_WIN + 16 * MiB;
constexpr size_t WS_WQ = WS_WOUT + 8 * MiB;
constexpr size_t WS_WK = WS_WQ + 8 * MiB;
constexpr size_t WS_WV = WS_WK + 8 * MiB;
constexpr size_t WS_WO = WS_WV + 8 * MiB;
constexpr size_t WS_PW = WS_WO + 8 * MiB;
constexpr size_t WS_WR = WS_PW + 1 * MiB;
constexpr size_t WS_WGU = WS_WR + 1 * MiB;
constexpr size_t WS_WD = WS_WGU + 512 * MiB;
constexpr size_t WS_HN = WS_WD + 256 * MiB;
constexpr size_t WS_MEMN = WS_HN + 32 * MiB;
constexpr size_t WS_P = WS_MEMN + 2 * MiB;
constexpr size_t WS_DTRAW = WS_P + 64 * MiB;
constexpr size_t WS_ACS = WS_DTRAW + 1 * MiB;
constexpr size_t WS_CDEC = WS_ACS + 1 * MiB;
constexpr size_t WS_KMEM = WS_CDEC + 1 * MiB;
constexpr size_t WS_VT = WS_KMEM + 2 * MiB;
constexpr size_t WS_XS = WS_VT + 2 * MiB;
constexpr size_t WS_CMG = WS_XS + 16 * MiB;
constexpr size_t WS_YDIAG = WS_CMG + 8 * MiB;
constexpr size_t WS_STATES = WS_YDIAG + 32 * MiB;
constexpr size_t WS_PREV = WS_STATES + 32 * MiB;
constexpr size_t WS_YCAT = WS_PREV + 16 * MiB;
constexpr size_t WS_H1 = WS_YCAT + 32 * MiB;
constexpr size_t WS_H2 = WS_H1 + 64 * MiB;
constexpr size_t WS_Q = WS_H2 + 64 * MiB;
constexpr size_t WS_O = WS_Q + 32 * MiB;
constexpr size_t WS_TOK = WS_O + 32 * MiB;
constexpr size_t WS_REC = WS_TOK + 1 * MiB;
constexpr size_t WS_ACT = WS_REC + 1 * MiB;
constexpr size_t WS_Y = WS_ACT + 162 * MiB;
constexpr size_t WS_END = WS_Y + 162 * MiB;
static_assert((size_t)SLOT_CAP * 2048 * 2 <= 162 * MiB, "act");

constexpr int CW_BAR = 4096;
constexpr int CW_CNT = 16384;

constexpr int LDS_BYTES = 147456;
constexpr int MISC_OFF = 146944;

#define LDS_WAIT() asm volatile("s_waitcnt lgkmcnt(0)" ::: "memory")
#define VM_WAIT() asm volatile("s_waitcnt vmcnt(0)" ::: "memory")

__device__ __forceinline__ unsigned f2bf(float f) { unsigned u = __builtin_bit_cast(unsigned, f); return (u + 0x7fffu + ((u >> 16) & 1u)) >> 16; }
typedef __bf16 bf16x2_t __attribute__((ext_vector_type(2)));
__device__ __forceinline__ unsigned pk2(float lo, float hi) { const f32x2 v = {lo, hi}; const bf16x2_t b = __builtin_convertvector(v, bf16x2_t); return __builtin_bit_cast(unsigned, b); }
__device__ __forceinline__ float bf2f(unsigned b) { return __builtin_bit_cast(float, b << 16); }
__device__ __forceinline__ float bflo(unsigned w) { return __builtin_bit_cast(float, w << 16); }
__device__ __forceinline__ float bfhi(unsigned w) { return __builtin_bit_cast(float, w & 0xffff0000u); }
__device__ __forceinline__ float wave_sum(float v) {
#pragma unroll
    for (int o = 1; o < 64; o <<= 1) v += __shfl_xor(v, o);
    return v;
}
__device__ __forceinline__ float siluf(float x) { return x / (1.0f + __expf(-x)); }

namespace pg8 {
constexpr int BM = 256, BK = 64, HALF = 128, HTB = HALF * BK * 2, STAGE_BYTES = 8 * HTB, KD = 2048;
__host__ __device__ __forceinline__ int lds_byte(int r, int c) { const int st = (r >> 4) * 2 + (c >> 5), rr = r & 15, cc = c & 31, ob = rr * 64 + cc * 2; return st * 1024 + (ob ^ (((ob >> 9) & 1) << 5)); }
__host__ __device__ __forceinline__ void stage_rc(int b, int& R, int& C) { const int st = b / 1024, sb = b % 1024, swz = sb ^ (((sb >> 9) & 1) << 5); R = (st >> 1) * 16 + swz / 64; C = (st & 1) * 32 + (swz % 64) / 2; }
__host__ __device__ __forceinline__ int perm32(int rho) { const int n = rho >> 4, i = rho & 15; return 8 * (i >> 2) + 4 * n + (i & 3); }

struct Unit { const char* A; const char* B; char* O; const int* tok; int ldc, row0, col0, e, cnt; };

template <int SC> struct EpiBf16P {
    static constexpr bool PERM = true;
    __device__ __forceinline__ void operator()(const f32x4 (&acc)[2][2][4][2], const Unit& u, int wr, int wc, int fr, int fq) const {
        const float scale = SC ? 0.04419417382415922f : 1.0f;
        const int rowt = wr * 64 + fr, colt = wc * 32 + 8 * fq;
        bf16* base = (bf16*)u.O;
#pragma unroll
        for (int ai = 0; ai < 2; ++ai)
#pragma unroll
            for (int m = 0; m < 4; ++m) { bf16* rowp = base + (size_t)(u.row0 + rowt + ai * HALF + m * 16) * u.ldc + u.col0 + colt;
#pragma unroll
                for (int bj = 0; bj < 2; ++bj) { const f32x4 v0 = acc[ai][bj][m][0] * scale, v1 = acc[ai][bj][m][1] * scale;
                    u32x4 w; w.x = pk2(v0[0], v0[1]); w.y = pk2(v0[2], v0[3]); w.z = pk2(v1[0], v1[1]); w.w = pk2(v1[2], v1[3]);
                    *(u32x4*)(rowp + bj * HALF) = w; } }
    }
};
struct EpiBf16B {
    static constexpr bool PERM = true;
    const float* bias; int bias_stride;
    __device__ __forceinline__ void operator()(const f32x4 (&acc)[2][2][4][2], const Unit& u, int wr, int wc, int fr, int fq) const {
        const int rowt = wr * 64 + fr, colt = wc * 32 + 8 * fq;
        bf16* base = (bf16*)u.O;
        f32x4 bv[2][2];
#pragma unroll
        for (int bj = 0; bj < 2; ++bj)
#pragma unroll
            for (int n = 0; n < 2; ++n) bv[bj][n] = *(const f32x4*)(bias + (size_t)u.e * bias_stride + u.col0 + colt + bj * HALF + 4 * n);
#pragma unroll
        for (int ai = 0; ai < 2; ++ai)
#pragma unroll
            for (int m = 0; m < 4; ++m) { bf16* rowp = base + (size_t)(u.row0 + rowt + ai * HALF + m * 16) * u.ldc + u.col0 + colt;
#pragma unroll
                for (int bj = 0; bj < 2; ++bj) { const f32x4 v0 = acc[ai][bj][m][0] + bv[bj][0], v1 = acc[ai][bj][m][1] + bv[bj][1];
                    u32x4 w; w.x = pk2(v0[0], v0[1]); w.y = pk2(v0[2], v0[3]); w.z = pk2(v1[0], v1[1]); w.w = pk2(v1[2], v1[3]);
                    *(u32x4*)(rowp + bj * HALF) = w; } }
    }
};
struct EpiF32Res {
    static constexpr bool PERM = false;
    const float* base; float* out; int ldc;
    __device__ __forceinline__ void operator()(const f32x4 (&acc)[2][2][4][2], const Unit& u, int wr, int wc, int fr, int fq) const {
        const int row0 = u.row0 + wr * 64 + fr, col0 = u.col0 + wc * 32 + 4 * fq;
#pragma unroll
        for (int ai = 0; ai < 2; ++ai)
#pragma unroll
            for (int m = 0; m < 4; ++m) { const size_t off = (size_t)(row0 + ai * HALF + m * 16) * ldc + col0;
#pragma unroll
                for (int bj = 0; bj < 2; ++bj)
#pragma unroll
                    for (int n = 0; n < 2; ++n) { const f32x4 bs = *(const f32x4*)(base + off + bj * HALF + n * 16); *(f32x4*)(out + off + bj * HALF + n * 16) = bs + acc[ai][bj][m][n]; } }
    }
};
struct EpiSwiglu {
    static constexpr bool PERM = true;
    const float* bg; const float* bu;
    __device__ __forceinline__ void operator()(const f32x4 (&acc)[2][2][4][2], const Unit& u, int wr, int wc, int fr, int fq) const {
        const int rowt = wr * 64 + fr, colt = u.col0 + wc * 32 + 8 * fq;
        bf16* base = (bf16*)u.O;
        f32x4 g_[2], u_[2];
#pragma unroll
        for (int n = 0; n < 2; ++n) { g_[n] = *(const f32x4*)(bg + (size_t)u.e * 2048 + colt + 4 * n); u_[n] = *(const f32x4*)(bu + (size_t)u.e * 2048 + colt + 4 * n); }
#pragma unroll
        for (int ai = 0; ai < 2; ++ai)
#pragma unroll
            for (int m = 0; m < 4; ++m) { bf16* rowp = base + (size_t)(u.row0 + rowt + ai * HALF + m * 16) * 2048 + colt;
                float a[8];
#pragma unroll
                for (int n = 0; n < 2; ++n)
#pragma unroll
                    for (int j = 0; j < 4; ++j) { float g = acc[ai][0][m][n][j] + g_[n][j], up = acc[ai][1][m][n][j] + u_[n][j];
                        g = fminf(g, 7.0f); up = fminf(fmaxf(up, -7.0f), 7.0f);
                        a[n * 4 + j] = g * __builtin_amdgcn_rcpf(1.0f + __expf(-1.702f * g)) * (up + 1.0f); }
                u32x4 w; w.x = pk2(a[0], a[1]); w.y = pk2(a[2], a[3]); w.z = pk2(a[4], a[5]); w.w = pk2(a[6], a[7]);
                *(u32x4*)rowp = w; }
    }
};

template <class Epi, class Sched, bool GATHER>
__device__ __forceinline__ void gemm_phase(LAS unsigned char* lds, const Sched& S, const Epi& E) {
    const int tid = threadIdx.x, wid = __builtin_amdgcn_readfirstlane(tid >> 6), lane = tid & 63, wr = wid >> 2, wc = wid & 3, fr = lane & 15, fq = lane >> 4;
    constexpr int K = KD, nt = K / BK;
    unsigned voffA[2][2], voffB[2];
#pragma unroll
    for (int i = 0; i < 2; ++i) { int R, C; stage_rc(tid * 16 + i * 8192, R, C); const int Rb = Epi::PERM ? ((R & ~31) + perm32(R & 31)) : R;
        voffA[0][i] = (unsigned)(R * K + C) * 2u; voffA[1][i] = (unsigned)((R + HALF) * K + C) * 2u; voffB[i] = (unsigned)(Rb * K + C) * 2u; }
    constexpr size_t kstep = (size_t)(BK * 2);
    constexpr size_t hstep = (size_t)HALF * K * 2;
    const unsigned ldsw = (unsigned)wid * 1024u;
    const int aoff = lds_byte(wr * 64 + fr, fq * 8), boff = lds_byte(wc * 32 + fr, fq * 8);
#define PG8_SA(b, h) (((b) * 2 + (h)) * HTB)
#define PG8_SB(b, h) ((4 + (b) * 2 + (h)) * HTB)
#define PG8_STAGE(bufoff, gbase, voff) do { _Pragma("unroll") for (int _i = 0; _i < 2; ++_i) \
        __builtin_amdgcn_global_load_lds((const unsigned*)((const char*)(gbase) + (voff)[_i]), (LAS unsigned*)(lds + (bufoff) + ldsw + _i * 8192), 16, 0, 0); } while (0)
#define PG8_LDA(dst, b, h) do { _Pragma("unroll") for (int m = 0; m < 4; ++m) _Pragma("unroll") for (int k = 0; k < 2; ++k) dst[m][k] = *(const LAS bf16x8*)(lds + PG8_SA(b, h) + aoff + m * 2048 + k * 1024); } while (0)
#define PG8_LDB(dst, b, h) do { _Pragma("unroll") for (int n = 0; n < 2; ++n) _Pragma("unroll") for (int k = 0; k < 2; ++k) dst[n][k] = *(const LAS bf16x8*)(lds + PG8_SB(b, h) + boff + n * 2048 + k * 1024); } while (0)
#define PG8_MMA(ai, bj, At, Bt) do { __builtin_amdgcn_s_setprio(1); _Pragma("unroll") for (int m = 0; m < 4; ++m) _Pragma("unroll") for (int n = 0; n < 2; ++n) _Pragma("unroll") for (int k = 0; k < 2; ++k) \
        acc[ai][bj][m][n] = __builtin_amdgcn_mfma_f32_16x16x32_bf16(Bt[n][k], At[m][k], acc[ai][bj][m][n], 0, 0, 0); __builtin_amdgcn_s_setprio(0); } while (0)
#define PG8_WAIT_V(n) asm volatile("s_waitcnt vmcnt(" #n ")" ::: "memory")
#define PG8_WAIT_L(n) asm volatile("s_waitcnt lgkmcnt(" #n ")" ::: "memory")
#define PG8_BAR __builtin_amdgcn_s_barrier()
#define PG8_SCHED __builtin_amdgcn_sched_barrier(0)
#define PG8_GATHER(dst, u) do { _Pragma("unroll") for (int _i = 0; _i < 2; ++_i) { int _R, _C; stage_rc(tid * 16 + _i * 8192, _R, _C); _Pragma("unroll") for (int _h = 0; _h < 2; ++_h) { const int _idx = _h * HALF + _R; \
        const int _t = (_idx < (u).cnt) ? (u).tok[_idx] : 0; dst[_h][_i] = (unsigned)(_t * K + _C) * 2u; } } } while (0)
    Unit cur, nxt; int ui = 0;
    if (!S.next(0, cur)) return;
    f32x4 acc[2][2][4][2];
#pragma unroll
    for (int a = 0; a < 2; ++a)
#pragma unroll
        for (int b = 0; b < 2; ++b)
#pragma unroll
            for (int m = 0; m < 4; ++m)
#pragma unroll
                for (int n = 0; n < 2; ++n) acc[a][b][m][n] = (f32x4){0.f, 0.f, 0.f, 0.f};
    bf16x8 At[4][2], B0[2][2], B1[2][2];
    const char* cA = cur.A; const char* cB = cur.B;
    if constexpr (GATHER) { PG8_GATHER(voffA, cur); }
    PG8_STAGE(PG8_SB(0, 0), cB, voffB); PG8_STAGE(PG8_SB(0, 1), cB + hstep, voffB); PG8_STAGE(PG8_SA(0, 0), cA, voffA[0]); PG8_STAGE(PG8_SA(0, 1), cA, voffA[1]);
    if (wr == 1) PG8_BAR;
    PG8_WAIT_V(2); PG8_BAR;
    PG8_STAGE(PG8_SB(1, 0), cB + kstep, voffB); PG8_STAGE(PG8_SA(1, 0), cA + kstep, voffA[0]); PG8_STAGE(PG8_SB(1, 1), cB + hstep + kstep, voffB);
    PG8_WAIT_V(6); PG8_BAR;
    for (;;) {
        const bool has_next = S.next(ui + 1, nxt);
        const char* nA = has_next ? nxt.A : cA; const char* nB = has_next ? nxt.B : cB;
        for (int t = 0; t < nt; t += 2) {
            const bool last = (t == nt - 2);
            const char* a1 = cA + (size_t)(t + 1) * kstep;
            const char* a2 = last ? nA : cA + (size_t)(t + 2) * kstep; const char* b2 = last ? nB : cB + (size_t)(t + 2) * kstep;
            const char* a3 = a2 + kstep; const char* b3 = b2 + kstep;
            PG8_LDB(B0, 0, 0); PG8_LDB(B1, 0, 1); PG8_SCHED; PG8_LDA(At, 0, 0); PG8_STAGE(PG8_SA(1, 1), a1, voffA[1]);
            PG8_WAIT_V(8); PG8_WAIT_L(0); PG8_BAR; PG8_MMA(0, 0, At, B0); PG8_MMA(0, 1, At, B1); PG8_BAR; PG8_SCHED;
            if constexpr (GATHER) { if (last && has_next) { PG8_GATHER(voffA, nxt); } }
            PG8_LDA(At, 0, 1); PG8_STAGE(PG8_SB(0, 0), b2, voffB); PG8_STAGE(PG8_SB(0, 1), b2 + hstep, voffB); PG8_STAGE(PG8_SA(0, 0), a2, voffA[0]);
            PG8_WAIT_V(8); PG8_WAIT_L(0); PG8_BAR; PG8_MMA(1, 0, At, B0); PG8_MMA(1, 1, At, B1); PG8_BAR; PG8_SCHED;
            PG8_LDB(B0, 1, 0); PG8_LDB(B1, 1, 1); PG8_SCHED; PG8_LDA(At, 1, 0); PG8_STAGE(PG8_SA(0, 1), a2, voffA[1]);
            PG8_WAIT_V(8); PG8_WAIT_L(0); PG8_BAR; PG8_MMA(0, 0, At, B0); PG8_MMA(0, 1, At, B1); PG8_BAR; PG8_SCHED;
            PG8_LDA(At, 1, 1); PG8_STAGE(PG8_SB(1, 0), b3, voffB); PG8_STAGE(PG8_SB(1, 1), b3 + hstep, voffB); PG8_STAGE(PG8_SA(1, 0), a3, voffA[0]);
            PG8_WAIT_V(8); PG8_WAIT_L(0); PG8_BAR; PG8_MMA(1, 0, At, B0); PG8_MMA(1, 1, At, B1); PG8_BAR; PG8_SCHED;
        }
        if (wr == 0) PG8_BAR;
        E(acc, cur, wr, wc, fr, fq);
        if (!has_next) break;
#pragma unroll
        for (int a = 0; a < 2; ++a)
#pragma unroll
            for (int b = 0; b < 2; ++b)
#pragma unroll
                for (int m = 0; m < 4; ++m)
#pragma unroll
                    for (int n = 0; n < 2; ++n) acc[a][b][m][n] = (f32x4){0.f, 0.f, 0.f, 0.f};
        cur = nxt; cA = nA; cB = nB; ++ui;
        if (wr == 1) PG8_BAR;
    }
    PG8_WAIT_V(0);
    PG8_BAR;
#undef PG8_SA
#undef PG8_SB
#undef PG8_STAGE
#undef PG8_LDA
#undef PG8_LDB
#undef PG8_MMA
#undef PG8_WAIT_V
#undef PG8_WAIT_L
#undef PG8_BAR
#undef PG8_SCHED
#undef PG8_GATHER
}
}

#define XB_TMO      128
#define XB_XCNT(j)  (256  + 64 * (j))
#define XB_XSUB(j)  (1280 + 64 * (j))
#define XB_XGEN(j)  (2304 + 64 * (j))
#define XB_TOP      3328
#define XB_TOPGEN   3392
#define XCD_BAR_WORDS 3456
#define XB_SPIN_CAP (1u << 18)
__device__ __forceinline__ unsigned xb_ld(unsigned* p)              { return __hip_atomic_load(p, __ATOMIC_RELAXED, __HIP_MEMORY_SCOPE_AGENT); }
__device__ __forceinline__ unsigned xb_add(unsigned* p, unsigned v) { return __hip_atomic_fetch_add(p, v, __ATOMIC_RELAXED, __HIP_MEMORY_SCOPE_AGENT); }
__device__ __forceinline__ unsigned xb_xcc_id() { return (unsigned)__builtin_amdgcn_s_getreg((3 << 11) | 20) & 0xFu; }
#define XB_SPIN(cond, bar) do { unsigned _sp = 0; while (cond) { __builtin_amdgcn_s_sleep(1); \
    if ((++_sp & 255u) == 0u) { if (xb_ld(&(bar)[XB_TMO])) break; if (_sp > XB_SPIN_CAP) { atomicAdd(&(bar)[XB_TMO], 1u); break; } } } } while (0)
struct XcdBarrier { unsigned* bar; unsigned x; volatile LAS unsigned* st; };
__device__ __forceinline__ XcdBarrier xcd_barrier_post(unsigned* bar, volatile LAS unsigned* st) {
    XcdBarrier b; b.bar = bar; b.x = xb_xcc_id(); b.st = st;
    if (threadIdx.x == 0) (void)xb_add(&bar[XB_XCNT(b.x)], 1u);
    return b;
}
__device__ __forceinline__ void xcd_barrier_complete(unsigned* bar, unsigned x, unsigned& nloc, unsigned& nx) {
    const unsigned G = gridDim.x * gridDim.y * gridDim.z;
    unsigned sum, cnt, mine, sp = 0u;
    for (;;) {
        sum = 0u; cnt = 0u; mine = 0u;
#pragma unroll
        for (unsigned j = 0; j < 16; ++j) { const unsigned c = xb_ld(&bar[XB_XCNT(j)]); sum += c; cnt += (c > 0u) ? 1u : 0u; mine = (j == x) ? c : mine; }
        if (sum == G) break;
        __builtin_amdgcn_s_sleep(1);
        if ((++sp & 255u) == 0u) { if (xb_ld(&bar[XB_TMO])) break; if (sp > XB_SPIN_CAP) { atomicAdd(&bar[XB_TMO], 1u); break; } }
    }
    nloc = mine > 0u ? mine : 1u; nx = cnt > 0u ? cnt : 1u;
}
__device__ __forceinline__ void xcd_barrier(const XcdBarrier& b) {
    asm volatile("s_waitcnt vmcnt(0)" ::: "memory");
    __syncthreads();
    if (threadIdx.x == 0) {
        unsigned* bar = b.bar;
        __builtin_amdgcn_s_waitcnt(0);
        unsigned nloc = b.st[0], nx = b.st[1];
        if (nloc == 0u) { xcd_barrier_complete(bar, b.x, nloc, nx); b.st[0] = nloc; b.st[1] = nx; }
        const unsigned old = xb_add(&bar[XB_XSUB(b.x)], 1u);
        const unsigned gen = old / nloc;
        if (old + 1u == (gen + 1u) * nloc) {
            __builtin_amdgcn_fence(__ATOMIC_RELEASE, "agent");
            asm volatile("s_waitcnt vmcnt(0)" ::: "memory");
            const unsigned og = xb_add(&bar[XB_TOP], 1u);
            const unsigned tg = og / nx;
            if (og + 1u == (tg + 1u) * nx) xb_add(&bar[XB_TOPGEN], 1u);
            else XB_SPIN(xb_ld(&bar[XB_TOPGEN]) == tg, bar);
            __builtin_amdgcn_fence(__ATOMIC_ACQUIRE, "agent");
            xb_add(&bar[XB_XGEN(b.x)], 1u);
            asm volatile("s_waitcnt vmcnt(0)" ::: "memory");
        } else {
            XB_SPIN(xb_ld(&bar[XB_XGEN(b.x)]) == gen, bar);
            __builtin_amdgcn_fence(__ATOMIC_ACQUIRE, "agent");
            asm volatile("s_waitcnt vmcnt(0)" ::: "memory");
        }
    }
    __syncthreads();
}

struct Args {
    const float* in[28];
    float* out; unsigned char* ws;
    int ph_lo, ph_hi, li, pad;
};
enum { I_X = 0, I_MEM, I_NORM_MIX, I_W_IN, I_CONV_W, I_CONV_B, I_DT_BIAS, I_A_LOG, I_D_SKIP, I_SSD_NORM, I_POOL_W, I_POOL_SCALE, I_W_OUT, I_NORM_XATTN, I_NORM_MEM,
       I_W_Q, I_W_KV, I_W_O, I_NORM_FFN, I_W_ROUTER, I_B_ROUTER, I_W_GATE, I_B_GATE, I_W_UP, I_B_UP, I_W_DOWN, I_B_DOWN, I_NORM_FINAL };

template <int MT, int NT>
__device__ __forceinline__ void wave_mma(f32x4 (&acc)[MT][NT], const LAS bf16* A, int lda, const LAS bf16* Bt, int ldb, int K, int lane) {
    const int fr = lane & 15, fq = lane >> 4;
    for (int k0 = 0; k0 < K; k0 += 32) {
        bf16x8 a[MT], b[NT];
#pragma unroll
        for (int m = 0; m < MT; ++m) a[m] = *(const LAS bf16x8*)(A + (m * 16 + fr) * lda + k0 + fq * 8);
#pragma unroll
        for (int n = 0; n < NT; ++n) b[n] = *(const LAS bf16x8*)(Bt + (n * 16 + fr) * ldb + k0 + fq * 8);
#pragma unroll
        for (int m = 0; m < MT; ++m)
#pragma unroll
            for (int n = 0; n < NT; ++n) acc[m][n] = __builtin_amdgcn_mfma_f32_16x16x32_bf16(b[n], a[m], acc[m][n], 0, 0, 0);
    }
}
__device__ __forceinline__ void tile_g2l(LAS bf16* dst, int ldd, const bf16* src, size_t lds_, int rows, int cols, int tid) {
    const int vpr = cols >> 3, nv = rows * vpr;
    for (int i = tid; i < nv; i += NTHREADS) { const int r = i / vpr, c = i - r * vpr; *(LAS u32x4*)(dst + r * ldd + c * 8) = *(const u32x4*)(src + (size_t)r * lds_ + c * 8); }
}

__device__ __forceinline__ void transpose_block(const float* W, int ldw, int k0, bf16* dstrow, int Kd, int lane, int nvalid) {
    if (lane < nvalid) {
        const float* s = W + (size_t)k0 * ldw + lane;
        float v[64];
#pragma unroll
        for (int i = 0; i < 64; ++i) v[i] = s[(size_t)i * ldw];
        bf16* d = dstrow + (size_t)lane * Kd + k0;
#pragma unroll
        for (int j = 0; j < 8; ++j) { u32x4 o; o.x = pk2(v[8 * j], v[8 * j + 1]); o.y = pk2(v[8 * j + 2], v[8 * j + 3]); o.z = pk2(v[8 * j + 4], v[8 * j + 5]); o.w = pk2(v[8 * j + 6], v[8 * j + 7]);
            *(u32x4*)(d + 8 * j) = o; }
    }
}
struct ConvDesc { const float* src; bf16* dst; int ldw, K, srccol0, ncb, nexp, mode; size_t src_es, dst_es; };

__device__ __forceinline__ void conv_matrix(const ConvDesc& d, int gw, int NGW, int lane) {
    const int nkb = d.K / 64, per = nkb * d.ncb, total = per * d.nexp;
    for (int it = gw; it < total; it += NGW) {
        const int e = it / per, r = it - e * per, kb = r / d.ncb, nb = r - kb * d.ncb;
        const int n0 = nb * 64;
        int drow = n0;
        if (d.mode) drow = (n0 >> 7) * 256 + (n0 & 127) + (d.mode == 2 ? 128 : 0);
        transpose_block(d.src + (size_t)e * d.src_es + d.srccol0 + n0, d.ldw, kb * 64, d.dst + (size_t)e * d.dst_es + (size_t)drow * d.K, d.K, lane, 64);
    }
}

__device__ __forceinline__ void p0_prologue(const Args& a, LAS unsigned char* lds, int tid, int lane, int wave, int vcu, int G) {
    unsigned char* ws = a.ws;
    const int gw = vcu * NWAVES + wave, NGW = G * NWAVES;
    {
        ConvDesc d;
        d = ConvDesc{a.in[I_W_IN], (bf16*)(ws + WS_WIN), DIN, 2048, 0, 48, 1, 0, 0, 0}; conv_matrix(d, gw, NGW, lane);
        d = ConvDesc{a.in[I_W_IN], (bf16*)(ws + WS_WIN) + (size_t)3072 * 2048, DIN, 2048, 3088, 16, 1, 0, 0, 0}; conv_matrix(d, gw, NGW, lane);
        d = ConvDesc{a.in[I_W_OUT], (bf16*)(ws + WS_WOUT), 2048, 2048, 0, 32, 1, 0, 0, 0}; conv_matrix(d, gw, NGW, lane);
        d = ConvDesc{a.in[I_W_Q], (bf16*)(ws + WS_WQ), 2048, 2048, 0, 32, 1, 0, 0, 0}; conv_matrix(d, gw, NGW, lane);
        d = ConvDesc{a.in[I_W_KV], (bf16*)(ws + WS_WK), 4096, 2048, 0, 32, 1, 0, 0, 0}; conv_matrix(d, gw, NGW, lane);
        d = ConvDesc{a.in[I_W_KV], (bf16*)(ws + WS_WV), 4096, 2048, 2048, 32, 1, 0, 0, 0}; conv_matrix(d, gw, NGW, lane);
        d = ConvDesc{a.in[I_W_O], (bf16*)(ws + WS_WO), 2048, 2048, 0, 32, 1, 0, 0, 0}; conv_matrix(d, gw, NGW, lane);
        d = ConvDesc{a.in[I_POOL_W], (bf16*)(ws + WS_PW), 256, 256, 0, 4, 4, 0, (size_t)256 * 256, (size_t)256 * 256}; conv_matrix(d, gw, NGW, lane);
        d = ConvDesc{a.in[I_W_GATE], (bf16*)(ws + WS_WGU), 2048, 2048, 0, 32, NE, 1, (size_t)2048 * 2048, (size_t)4096 * 2048}; conv_matrix(d, gw, NGW, lane);
        d = ConvDesc{a.in[I_W_UP], (bf16*)(ws + WS_WGU), 2048, 2048, 0, 32, NE, 2, (size_t)2048 * 2048, (size_t)4096 * 2048}; conv_matrix(d, gw, NGW, lane);
        d = ConvDesc{a.in[I_W_DOWN], (bf16*)(ws + WS_WD), 2048, 2048, 0, 32, NE, 0, (size_t)2048 * 2048, (size_t)2048 * 2048}; conv_matrix(d, gw, NGW, lane);
        for (int kb = gw; kb < 32; kb += NGW) transpose_block(a.in[I_W_ROUTER], 32, kb * 64, (bf16*)(ws + WS_WR), 2048, lane, 32);
    }
    constexpr int WP = 2052;
    LAS float* wdt = (LAS float*)lds;
    {
        const float* w_in = a.in[I_W_IN];
        for (int i = tid; i < 2048 * 16; i += NTHREADS) { const int k = i >> 4, h = i & 15; wdt[h * WP + k] = w_in[(size_t)k * DIN + 3072 + h]; }
    }
    __syncthreads();
    {
        const float* x = a.in[I_X]; const float* nw = a.in[I_NORM_MIX];
        bf16* hn = (bf16*)(ws + WS_HN); float* dtraw = (float*)(ws + WS_DTRAW);
        f32x4 wv[8];
#pragma unroll
        for (int j = 0; j < 8; ++j) wv[j] = ((const f32x4*)nw)[lane + 64 * j];
        for (int m = gw; m < T; m += NGW) {
            const f32x4* xr = (const f32x4*)(x + (size_t)m * D) + lane;
            f32x4 v[8]; float ss = 0.f;
#pragma unroll
            for (int j = 0; j < 8; ++j) { v[j] = xr[64 * j]; ss += (v[j].x * v[j].x + v[j].y * v[j].y) + (v[j].z * v[j].z + v[j].w * v[j].w); }
            const float rstd = rsqrtf(wave_sum(ss) * (1.f / D) + EPS);
            u32x2* o8 = (u32x2*)(hn + (size_t)m * D) + lane;
#pragma unroll
            for (int j = 0; j < 8; ++j) { v[j] = v[j] * rstd * wv[j]; u32x2 w; w.x = pk2(v[j].x, v[j].y); w.y = pk2(v[j].z, v[j].w); o8[64 * j] = w; }
            float res = 0.f;
#pragma unroll 1
            for (int h = 0; h < 16; ++h) {
                const LAS f32x4* wr = (const LAS f32x4*)(wdt + h * WP) + lane; float p = 0.f;
#pragma unroll
                for (int j = 0; j < 8; ++j) { const f32x4 w4 = wr[64 * j]; p += (v[j].x * w4.x + v[j].y * w4.y) + (v[j].z * w4.z + v[j].w * w4.w); }
                p = wave_sum(p); if (lane == h) res = p;
            }
            if (lane < 16) dtraw[(size_t)m * 16 + lane] = res;
        }
    }
    {
        const float* x = a.in[I_MEM]; const float* nw = a.in[I_NORM_MEM]; bf16* o = (bf16*)(ws + WS_MEMN);
        for (int m = gw; m < NB * NMEM; m += NGW) {
            const f32x4* xr = (const f32x4*)(x + (size_t)m * D) + lane;
            f32x4 v[8]; float ss = 0.f;
#pragma unroll
            for (int j = 0; j < 8; ++j) { v[j] = xr[64 * j]; ss += (v[j].x * v[j].x + v[j].y * v[j].y) + (v[j].z * v[j].z + v[j].w * v[j].w); }
            const float rstd = rsqrtf(wave_sum(ss) * (1.f / D) + EPS);
            u32x2* o8 = (u32x2*)(o + (size_t)m * D) + lane;
#pragma unroll
            for (int j = 0; j < 8; ++j) { const f32x4 w4 = ((const f32x4*)nw)[lane + 64 * j]; v[j] = v[j] * rstd * w4; u32x2 w; w.x = pk2(v[j].x, v[j].y); w.y = pk2(v[j].z, v[j].w); o8[64 * j] = w; }
        }
    }
}

__device__ __forceinline__ void rms_rows_bf16(const float* src, const float* nw, bf16* o, int rows, int gw, int NGW, int lane) {
    f32x4 wv[8];
#pragma unroll
    for (int j = 0; j < 8; ++j) wv[j] = ((const f32x4*)nw)[lane + 64 * j];
    for (int m = gw; m < rows; m += NGW) {
        const f32x4* xr = (const f32x4*)(src + (size_t)m * D) + lane;
        f32x4 v[8]; float ss = 0.f;
#pragma unroll
        for (int j = 0; j < 8; ++j) { v[j] = xr[64 * j]; ss += (v[j].x * v[j].x + v[j].y * v[j].y) + (v[j].z * v[j].z + v[j].w * v[j].w); }
        const float rstd = rsqrtf(wave_sum(ss) * (1.f / D) + EPS);
        u32x2* o8 = (u32x2*)(o + (size_t)m * D) + lane;
#pragma unroll
        for (int j = 0; j < 8; ++j) { v[j] = v[j] * rstd * wv[j]; u32x2 w; w.x = pk2(v[j].x, v[j].y); w.y = pk2(v[j].z, v[j].w); o8[64 * j] = w; }
    }
}

struct DenseSched {
    const char* A; const char* B; char* O; int ldc; int nM, nN, nwg, G, c;
    __device__ __forceinline__ void decode(int L, int& pm, int& pn) const {
        int wgid = L; { const int q = nwg / 8, r = nwg % 8, xcd = wgid % 8, off = wgid / 8; wgid = (xcd < r ? xcd * (q + 1) : r * (q + 1) + (xcd - r) * q) + off; }
        const int nig = 8 * nN, gid = wgid / nig, fm = gid * 8, gsz = (nM - fm) < 8 ? (nM - fm) : 8;
        pm = fm + ((wgid % nig) % gsz); pn = (wgid % nig) / gsz;
    }
    __device__ __forceinline__ bool next(int i, pg8::Unit& u) const {
        const int L = i * G + c; if (L >= nwg) return false;
        int pm, pn; decode(L, pm, pn);
        u.A = A + (size_t)pm * 256 * 4096; u.B = B + (size_t)pn * 256 * 4096; u.O = O; u.ldc = ldc; u.row0 = pm * 256; u.col0 = pn * 256; u.e = 0; u.cnt = 0; u.tok = nullptr;
        return true;
    }
};
struct P1Sched {
    DenseSched inproj; const char* memn; const char* wk; const char* wv; char* kmem; char* vt; int G, c;
    __device__ __forceinline__ bool next(int i, pg8::Unit& u) const {
        const int L = i * G + c;
        if (L < 512) return inproj.next(i, u);
        const int r = L - 512; if (r >= 32) return false;
        u.e = 0; u.cnt = 0; u.tok = nullptr;
        if (r < 16) { const int pm = r & 1, pn = r >> 1; u.A = memn + (size_t)pm * 256 * 4096; u.B = wk + (size_t)pn * 256 * 4096; u.O = kmem; u.ldc = 2048; u.row0 = pm * 256; u.col0 = pn * 256; }
        else { const int q = r - 16, pm = q >> 1, pn = q & 1; u.A = wv + (size_t)pm * 256 * 4096; u.B = memn + (size_t)pn * 256 * 4096; u.O = vt; u.ldc = 512; u.row0 = pm * 256; u.col0 = pn * 256; }
        return true;
    }
};
struct MoeSched {
    const LAS int* tstart; const int* cnt; const int* tok; const char* A; const char* B; char* O; int nN, colw, G, c; size_t b_es; bool gather;
    __device__ __forceinline__ bool next(int i, pg8::Unit& u) const {
        const int L = i * G + c; const int ntile = tstart[NE];
        if (L >= ntile * nN) return false;
        const int mg = L / nN, pn = L - mg * nN;
        int e = 0;
#pragma unroll 1
        for (int j = 1; j < NE; ++j) e += (tstart[j] <= mg) ? 1 : 0;
        const int mt = mg - tstart[e];
        u.e = e; u.cnt = cnt[64 * e] - mt * 256; u.tok = tok + e * 8192 + mt * 256;
        u.A = gather ? A : A + (size_t)mg * 256 * 4096; u.B = B + (size_t)e * b_es + (size_t)pn * 256 * 4096; u.O = O; u.ldc = 2048; u.row0 = mg * 256; u.col0 = pn * colw;
        return true;
    }
};

constexpr int LD1 = 136;
__device__ __forceinline__ void ssd_chunk_unit(const Args& a, LAS unsigned char* lds, int unit, int tid, int lane, int wave) {
    unsigned char* ws = a.ws;
    const int g = unit & 3, c = (unit >> 2) & 31, b = unit >> 7;
    const int t0 = b * SEQ + c * CHUNK;
    const bf16* P = (const bf16*)(ws + WS_P);
    const float* conv_w = a.in[I_CONV_W]; const float* conv_b = a.in[I_CONV_B];
    LAS bf16* Cm = (LAS bf16*)lds;
    LAS bf16* Bm = (LAS bf16*)(lds + 34816);
    LAS bf16* BmT = (LAS bf16*)(lds + 69632);
    LAS bf16* XT = (LAS bf16*)lds;
    LAS bf16* Gs = (LAS bf16*)(lds + 104448);
    LAS float* dts = (LAS float*)(lds + 139264);
    LAS float* acss = dts + 512;
    LAS float* wls = acss + 512;
    const int fr = lane & 15, fq = lane >> 4;
    {
        const int half = tid >> 8, cc = tid & 255; const bool isC = cc >= 128; const int n = cc & 127;
        const int ch = (isC ? 1536 : 1024) + g * 128 + n;
        const float w0 = conv_w[ch], w1 = conv_w[DCONV + ch], w2 = conv_w[2 * DCONV + ch], w3 = conv_w[3 * DCONV + ch], cb = conv_b[ch];
        const int l0 = half * 64;
        const bf16* src = P + (size_t)t0 * PCOLS + 1024 + ch;
        float r0, r1, r2;
        { const int s = c * CHUNK + l0;
          r0 = (s - 3 >= 0) ? bf2f(src[(ptrdiff_t)(l0 - 3) * PCOLS]) : 0.f; r1 = (s - 2 >= 0) ? bf2f(src[(ptrdiff_t)(l0 - 2) * PCOLS]) : 0.f; r2 = (s - 1 >= 0) ? bf2f(src[(ptrdiff_t)(l0 - 1) * PCOLS]) : 0.f; }
        bf16* cmg = (bf16*)(ws + WS_CMG);
#pragma unroll 1
        for (int o = 0; o < 8; ++o) {
            float raw[8], ov[8];
#pragma unroll
            for (int i = 0; i < 8; ++i) raw[i] = bf2f(src[(size_t)(l0 + o * 8 + i) * PCOLS]);
#pragma unroll
            for (int i = 0; i < 8; ++i) { const float v = w0 * r0 + w1 * r1 + w2 * r2 + w3 * raw[i] + cb; ov[i] = siluf(v); r0 = r1; r1 = r2; r2 = raw[i]; }
            unsigned pk[4];
#pragma unroll
            for (int i = 0; i < 4; ++i) pk[i] = pk2(ov[2 * i], ov[2 * i + 1]);
            const int l = l0 + o * 8;
            if (!isC) {
                *(LAS u32x4*)(BmT + n * LD1 + l) = (u32x4){pk[0], pk[1], pk[2], pk[3]};
#pragma unroll
                for (int i = 0; i < 8; ++i) Bm[(l + i) * LD1 + n] = (bf16)((i & 1) ? (pk[i >> 1] >> 16) : (pk[i >> 1] & 0xffffu));
            } else {
#pragma unroll
                for (int i = 0; i < 8; ++i) { const bf16 hv = (bf16)((i & 1) ? (pk[i >> 1] >> 16) : (pk[i >> 1] & 0xffffu)); Cm[(l + i) * LD1 + n] = hv; cmg[(size_t)(t0 + l + i) * 512 + g * 128 + n] = hv; }
            }
        }
    }
    if (wave < 4) {
        const int h = g * 4 + wave;
        const float* dtraw = (const float*)(ws + WS_DTRAW);
        const float bias = a.in[I_DT_BIAS][h], av = -__expf(a.in[I_A_LOG][h]);
        float d0 = dtraw[(size_t)(t0 + 2 * lane) * 16 + h] + bias, d1 = dtraw[(size_t)(t0 + 2 * lane + 1) * 16 + h] + bias;
        d0 = d0 > 20.f ? d0 : log1pf(__expf(d0)); d1 = d1 > 20.f ? d1 : log1pf(__expf(d1));
        const float v0 = d0 * av, v1 = d1 * av;
        float s = v0 + v1;
#pragma unroll
        for (int o = 1; o < 64; o <<= 1) { const float t = __shfl_up(s, o); if (lane >= o) s += t; }
        const float acs1 = s, acs0 = s - v1;
        const float last = __shfl(s, 63);
        dts[wave * 128 + 2 * lane] = d0; dts[wave * 128 + 2 * lane + 1] = d1;
        acss[wave * 128 + 2 * lane] = acs0; acss[wave * 128 + 2 * lane + 1] = acs1;
        wls[wave * 128 + 2 * lane] = __expf(last - acs0) * d0; wls[wave * 128 + 2 * lane + 1] = __expf(last - acs1) * d1;
        float* acsg = (float*)(ws + WS_ACS);
        acsg[(size_t)(t0 + 2 * lane) * 16 + h] = acs0; acsg[(size_t)(t0 + 2 * lane + 1) * 16 + h] = acs1;
        if (lane == 0) ((float*)(ws + WS_CDEC))[(b * NCH + c) * 16 + h] = __expf(last);
    }
    __syncthreads();
    f32x4 cbv[1][8];
#pragma unroll
    for (int n = 0; n < 8; ++n) cbv[0][n] = (f32x4){0.f, 0.f, 0.f, 0.f};
    wave_mma<1, 8>(cbv, Cm + wave * 16 * LD1, LD1, Bm, LD1, 128, lane);
    __syncthreads();
    {
        const int half = tid >> 8, cc = tid & 255;
        const int ch = g * 256 + cc;
        const float w0 = conv_w[ch], w1 = conv_w[DCONV + ch], w2 = conv_w[2 * DCONV + ch], w3 = conv_w[3 * DCONV + ch], cb = conv_b[ch];
        const int l0 = half * 64;
        const bf16* src = P + (size_t)t0 * PCOLS + 1024 + ch;
        float r0, r1, r2;
        { const int s = c * CHUNK + l0;
          r0 = (s - 3 >= 0) ? bf2f(src[(ptrdiff_t)(l0 - 3) * PCOLS]) : 0.f; r1 = (s - 2 >= 0) ? bf2f(src[(ptrdiff_t)(l0 - 2) * PCOLS]) : 0.f; r2 = (s - 1 >= 0) ? bf2f(src[(ptrdiff_t)(l0 - 1) * PCOLS]) : 0.f; }
        bf16* xs = (bf16*)(ws + WS_XS);
#pragma unroll 1
        for (int o = 0; o < 8; ++o) {
            float raw[8], ov[8];
#pragma unroll
            for (int i = 0; i < 8; ++i) raw[i] = bf2f(src[(size_t)(l0 + o * 8 + i) * PCOLS]);
#pragma unroll
            for (int i = 0; i < 8; ++i) { const float v = w0 * r0 + w1 * r1 + w2 * r2 + w3 * raw[i] + cb; ov[i] = siluf(v); r0 = r1; r1 = r2; r2 = raw[i]; }
            unsigned pk[4];
#pragma unroll
            for (int i = 0; i < 4; ++i) pk[i] = pk2(ov[2 * i], ov[2 * i + 1]);
            const int l = l0 + o * 8;
            *(LAS u32x4*)(XT + cc * LD1 + l) = (u32x4){pk[0], pk[1], pk[2], pk[3]};
#pragma unroll
            for (int i = 0; i < 8; ++i) xs[(size_t)(t0 + l + i) * 1024 + ch] = (bf16)((i & 1) ? (pk[i >> 1] >> 16) : (pk[i >> 1] & 0xffffu));
        }
    }
    __syncthreads();
    const int lrow = wave * 16 + fr;
#pragma unroll 1
    for (int r = 0; r < 4; ++r) {
        const int h = g * 4 + r;
        const float al = acss[r * 128 + lrow];
        LAS bf16* grow = Gs + lrow * LD1;
#pragma unroll
        for (int n = 0; n < 8; ++n) {
            const int s0 = n * 16 + 4 * fq;
            const f32x4 as = *(const LAS f32x4*)(acss + r * 128 + s0), ds = *(const LAS f32x4*)(dts + r * 128 + s0);
            float gv[4];
#pragma unroll
            for (int j = 0; j < 4; ++j) { const float df = fminf(al - as[j], 0.f); gv[j] = (s0 + j <= lrow) ? cbv[0][n][j] * __expf(df) * ds[j] : 0.f; }
            *(LAS u32x2*)(grow + s0) = (u32x2){pk2(gv[0], gv[1]), pk2(gv[2], gv[3])};
        }
        LDS_WAIT(); __builtin_amdgcn_wave_barrier();
        f32x4 yd[1][4];
#pragma unroll
        for (int n = 0; n < 4; ++n) yd[0][n] = (f32x4){0.f, 0.f, 0.f, 0.f};
        wave_mma<1, 4>(yd, Gs + wave * 16 * LD1, LD1, XT + r * 64 * LD1, LD1, 128, lane);
        float* ydg = (float*)(ws + WS_YDIAG) + (size_t)(t0 + lrow) * 1024 + h * 64;
#pragma unroll
        for (int n = 0; n < 4; ++n) *(f32x4*)(ydg + n * 16 + 4 * fq) = yd[0][n];
        f32x4 st[4];
#pragma unroll
        for (int n = 0; n < 4; ++n) st[n] = (f32x4){0.f, 0.f, 0.f, 0.f};
        const LAS bf16* xa = XT + (r * 64 + (wave & 3) * 16 + fr) * LD1;
        const LAS bf16* bt = BmT + ((wave >> 2) * 64 + fr) * LD1;
#pragma unroll
        for (int k0 = 0; k0 < 128; k0 += 32) {
            const u32x4 xr = *(const LAS u32x4*)(xa + k0 + fq * 8);
            const f32x4 wa = *(const LAS f32x4*)(wls + r * 128 + k0 + fq * 8), wb = *(const LAS f32x4*)(wls + r * 128 + k0 + fq * 8 + 4);
            u32x4 xsq; xsq.x = pk2(bflo(xr.x) * wa[0], bfhi(xr.x) * wa[1]); xsq.y = pk2(bflo(xr.y) * wa[2], bfhi(xr.y) * wa[3]);
            xsq.z = pk2(bflo(xr.z) * wb[0], bfhi(xr.z) * wb[1]); xsq.w = pk2(bflo(xr.w) * wb[2], bfhi(xr.w) * wb[3]);
            const bf16x8 af = __builtin_bit_cast(bf16x8, xsq);
#pragma unroll
            for (int n = 0; n < 4; ++n) { const bf16x8 bfv = *(const LAS bf16x8*)(bt + n * 16 * LD1 + k0 + fq * 8); st[n] = __builtin_amdgcn_mfma_f32_16x16x32_bf16(bfv, af, st[n], 0, 0, 0); }
        }
        float* sg = (float*)(ws + WS_STATES) + ((size_t)((b * NCH + c) * 16 + h)) * 8192 + ((wave & 3) * 16 + fr) * 128 + (wave >> 2) * 64;
#pragma unroll
        for (int n = 0; n < 4; ++n) *(f32x4*)(sg + n * 16 + 4 * fq) = st[n];
        __builtin_amdgcn_wave_barrier();
    }
    __syncthreads();
}

constexpr int LD2 = 264;
__device__ __forceinline__ void pool_unit(const Args& a, LAS unsigned char* lds, int unit, int tid, int lane, int wave) {
    unsigned char* ws = a.ws;
    const int g = unit & 3, tt = unit >> 2;
    const int t0 = tt * 128, s0 = t0 & (SEQ - 1);
    const int w = 2 << g;
    const bf16* P = (const bf16*)(ws + WS_P);
    LAS bf16* U = (LAS bf16*)lds;
    LAS bf16* Ap = (LAS bf16*)(lds + 75504);
    LAS bf16* Bt = (LAS bf16*)lds;
    for (int i = tid; i < 143 * 32; i += NTHREADS) { const int r = i >> 5, cv = i & 31; const int s = s0 - 15 + r;
        u32x4 v = (u32x4){0u, 0u, 0u, 0u};
        if (s >= 0) v = *(const u32x4*)(P + (size_t)(t0 - 15 + r) * PCOLS + 3072 + g * 256 + cv * 8);
        *(LAS u32x4*)(U + r * LD2 + cv * 8) = v; }
    __syncthreads();
    {
        const int cc = tid & 255, l0 = (tid >> 8) * 64;
        float sum = 0.f;
        for (int j = 1; j < w; ++j) sum += bf2f(U[(15 + l0 - j) * LD2 + cc]);
        for (int l = l0; l < l0 + 64; ++l) {
            const float ucur = bf2f(U[(15 + l) * LD2 + cc]);
            sum += ucur;
            const int s = s0 + l; const float cntw = (float)((s + 1 < w) ? s + 1 : w);
            Ap[l * LD2 + cc] = (bf16)f2bf(sum / cntw - ucur);
            sum -= bf2f(U[(15 + l - w + 1) * LD2 + cc]);
        }
    }
    __syncthreads();
    const bf16* pw = (const bf16*)(ws + WS_PW) + (size_t)g * 256 * 256;
    const float* pscale = a.in[I_POOL_SCALE];
    bf16* ycat = (bf16*)(ws + WS_YCAT);
    const int fr = lane & 15, fq = lane >> 4;
#pragma unroll 1
    for (int hf = 0; hf < 2; ++hf) {
        tile_g2l(Bt, LD2, pw + (size_t)hf * 128 * 256, 256, 128, 256, tid);
        __syncthreads();
        f32x4 acc[1][8];
#pragma unroll
        for (int n = 0; n < 8; ++n) acc[0][n] = (f32x4){0.f, 0.f, 0.f, 0.f};
        wave_mma<1, 8>(acc, Ap + wave * 16 * LD2, LD2, Bt, LD2, 256, lane);
        bf16* orow = ycat + (size_t)(t0 + wave * 16 + fr) * 2048 + 1024 + g * 256 + hf * 128;
#pragma unroll
        for (int n = 0; n < 8; ++n) { const int d = n * 16 + 4 * fq; const f32x4 sc = *(const f32x4*)(pscale + g * 256 + hf * 128 + d); const f32x4 v = acc[0][n] * sc;
            *(u32x2*)(orow + d) = (u32x2){pk2(v[0], v[1]), pk2(v[2], v[3])}; }
        __syncthreads();
    }
}

__device__ __forceinline__ void ssd_combine_unit(const Args& a, LAS unsigned char* lds, int unit, int tid, int lane, int wave) {
    unsigned char* ws = a.ws;
    const int g = unit & 3, c = (unit >> 2) & 31, b = unit >> 7;
    const int t0 = b * SEQ + c * CHUNK;
    LAS bf16* Cm = (LAS bf16*)lds;
    LAS bf16* Pv = (LAS bf16*)(lds + 34816);
    tile_g2l(Cm, LD1, (const bf16*)(ws + WS_CMG) + (size_t)t0 * 512 + g * 128, 512, 128, 128, tid);
    tile_g2l(Pv, LD1, (const bf16*)(ws + WS_PREV) + ((size_t)((b * NCH + c) * 16 + g * 4)) * 8192, 128, 256, 128, tid);
    __syncthreads();
    const int fr = lane & 15, fq = lane >> 4;
    const int t = t0 + wave * 16 + fr;
    const bf16* P = (const bf16*)(ws + WS_P);
    const float* ydg = (const float*)(ws + WS_YDIAG) + (size_t)t * 1024;
    const bf16* xs = (const bf16*)(ws + WS_XS) + (size_t)t * 1024;
    const float* acsg = (const float*)(ws + WS_ACS) + (size_t)t * 16;
    f32x4 y[4][4]; float ss = 0.f;
#pragma unroll
    for (int r = 0; r < 4; ++r) {
        const int h = g * 4 + r;
        f32x4 yo[1][4];
#pragma unroll
        for (int n = 0; n < 4; ++n) yo[0][n] = (f32x4){0.f, 0.f, 0.f, 0.f};
        wave_mma<1, 4>(yo, Cm + wave * 16 * LD1, LD1, Pv + r * 64 * LD1, LD1, 128, lane);
        const float ea = __expf(acsg[h]), dsk = a.in[I_D_SKIP][h];
#pragma unroll
        for (int n = 0; n < 4; ++n) {
            const int col = h * 64 + n * 16 + 4 * fq;
            const f32x4 yd = *(const f32x4*)(ydg + col);
            const u32x2 xv = *(const u32x2*)(xs + col), zv = *(const u32x2*)(P + (size_t)t * PCOLS + col);
            const float xf[4] = {bflo(xv.x), bfhi(xv.x), bflo(xv.y), bfhi(xv.y)}, zf[4] = {bflo(zv.x), bfhi(zv.x), bflo(zv.y), bfhi(zv.y)};
#pragma unroll
            for (int j = 0; j < 4; ++j) { const float v = (yd[j] + yo[0][n][j] * ea + dsk * xf[j]) * siluf(zf[j]); y[r][n][j] = v; ss += v * v; }
        }
    }
    ss += __shfl_xor(ss, 16); ss += __shfl_xor(ss, 32);
    const float rstd = rsqrtf(ss * (1.f / 256.f) + EPS);
    const float* nw = a.in[I_SSD_NORM] + g * 256;
    bf16* orow = (bf16*)(ws + WS_YCAT) + (size_t)t * 2048 + g * 256;
#pragma unroll
    for (int r = 0; r < 4; ++r)
#pragma unroll
        for (int n = 0; n < 4; ++n) { const int col = r * 64 + n * 16 + 4 * fq; const f32x4 w4 = *(const f32x4*)(nw + col); const f32x4 v = y[r][n] * rstd * w4;
            *(u32x2*)(orow + col) = (u32x2){pk2(v[0], v[1]), pk2(v[2], v[3])}; }
    __syncthreads();
}

__device__ __forceinline__ void attn_unit(const Args& a, LAS unsigned char* lds, int unit, int tid, int lane, int wave) {
    unsigned char* ws = a.ws;
    const int h = unit & 3, qt = (unit >> 2) & 31, b = unit >> 7;
    const int t0 = b * SEQ + qt * 128;
    const bf16* q = (const bf16*)(ws + WS_Q); const bf16* km = (const bf16*)(ws + WS_KMEM); const bf16* vt = (const bf16*)(ws + WS_VT);
    LAS bf16* Qc = (LAS bf16*)lds;
    LAS bf16* Kc = (LAS bf16*)(lds + 34816);
    LAS bf16* Ps = (LAS bf16*)lds;
    LAS bf16* Vc = (LAS bf16*)(lds + 67584);
    const int fr = lane & 15, fq = lane >> 4;
    f32x4 s[1][16];
#pragma unroll
    for (int n = 0; n < 16; ++n) s[0][n] = (f32x4){0.f, 0.f, 0.f, 0.f};
#pragma unroll 1
    for (int dc = 0; dc < 4; ++dc) {
        tile_g2l(Qc, LD1, q + (size_t)t0 * 2048 + h * 512 + dc * 128, 2048, 128, 128, tid);
        tile_g2l(Kc, LD1, km + (size_t)(b * NMEM) * 2048 + h * 512 + dc * 128, 2048, 256, 128, tid);
        __syncthreads();
        wave_mma<1, 16>(s, Qc + wave * 16 * LD1, LD1, Kc, LD1, 128, lane);
        __syncthreads();
    }
    float mx = -3.0e38f;
#pragma unroll
    for (int n = 0; n < 16; ++n)
#pragma unroll
        for (int j = 0; j < 4; ++j) mx = fmaxf(mx, s[0][n][j]);
    mx = fmaxf(mx, __shfl_xor(mx, 16)); mx = fmaxf(mx, __shfl_xor(mx, 32));
    float sum = 0.f;
#pragma unroll
    for (int n = 0; n < 16; ++n)
#pragma unroll
        for (int j = 0; j < 4; ++j) { const float e = __expf(s[0][n][j] - mx); s[0][n][j] = e; sum += e; }
    sum += __shfl_xor(sum, 16); sum += __shfl_xor(sum, 32);
    const float inv = 1.0f / sum;
    LAS bf16* prow = Ps + (wave * 16 + fr) * LD2;
#pragma unroll
    for (int n = 0; n < 16; ++n) { const f32x4 p = s[0][n] * inv; *(LAS u32x2*)(prow + n * 16 + 4 * fq) = (u32x2){pk2(p[0], p[1]), pk2(p[2], p[3])}; }
    bf16* orow = (bf16*)(ws + WS_O) + (size_t)(t0 + wave * 16 + fr) * 2048 + h * 512;
#pragma unroll 1
    for (int dc = 0; dc < 4; ++dc) {
        tile_g2l(Vc, LD2, vt + (size_t)(h * 512 + dc * 128) * 512 + b * NMEM, 512, 128, 256, tid);
        __syncthreads();
        f32x4 o[1][8];
#pragma unroll
        for (int n = 0; n < 8; ++n) o[0][n] = (f32x4){0.f, 0.f, 0.f, 0.f};
        wave_mma<1, 8>(o, Ps + wave * 16 * LD2, LD2, Vc, LD2, 256, lane);
#pragma unroll
        for (int n = 0; n < 8; ++n) *(u32x2*)(orow + dc * 128 + n * 16 + 4 * fq) = (u32x2){pk2(o[0][n][0], o[0][n][1]), pk2(o[0][n][2], o[0][n][3])};
        __syncthreads();
    }
}

__device__ __forceinline__ void router_phase(const Args& a, LAS unsigned char* lds, int tid, int lane, int wave, int vcu, int G) {
    unsigned char* ws = a.ws;
    LAS bf16* wr = (LAS bf16*)lds;
    LAS int* pick_e = (LAS int*)(lds + 131072);
    LAS float* pick_g = (LAS float*)(lds + 131072 + 512);
    LAS int* pick_lp = (LAS int*)(lds + 131072 + 1024);
    LAS int* lcnt = (LAS int*)(lds + 131072 + 1536);
    LAS int* lbase = lcnt + 32;
    { const u32x4* src = (const u32x4*)(ws + WS_WR); for (int i = tid; i < 32 * 2048 / 8; i += NTHREADS) ((LAS u32x4*)wr)[i] = src[i]; }
    const float* h2 = (const float*)(ws + WS_H2); const float* nw = a.in[I_NORM_FFN]; const float* brt = a.in[I_B_ROUTER];
    bf16* hn = (bf16*)(ws + WS_HN);
    unsigned* ctl = (unsigned*)(ws + WS_CTL);
    int* tok_of = (int*)(ws + WS_TOK); int* rec_e = (int*)(ws + WS_REC); int* rec_p = rec_e + T * 4; float* rec_g = (float*)(rec_p + T * 4);
    for (int base = vcu * 32; base < T; base += G * 32) {
        if (tid < 32) lcnt[tid] = 0;
        __syncthreads();
#pragma unroll 1
        for (int i = 0; i < 4; ++i) {
            const int lr = wave * 4 + i, m = base + lr;
            const f32x4* xr = (const f32x4*)(h2 + (size_t)m * D) + lane;
            f32x4 v[8]; float ss = 0.f;
#pragma unroll
            for (int j = 0; j < 8; ++j) { v[j] = xr[64 * j]; ss += (v[j].x * v[j].x + v[j].y * v[j].y) + (v[j].z * v[j].z + v[j].w * v[j].w); }
            const float rstd = rsqrtf(wave_sum(ss) * (1.f / D) + EPS);
            u32x2* o8 = (u32x2*)(hn + (size_t)m * D) + lane;
#pragma unroll
            for (int j = 0; j < 8; ++j) { const f32x4 w4 = ((const f32x4*)nw)[lane + 64 * j]; v[j] = v[j] * rstd * w4; u32x2 w; w.x = pk2(v[j].x, v[j].y); w.y = pk2(v[j].z, v[j].w); o8[64 * j] = w; }
            float lg = -3.0e38f;
#pragma unroll 1
            for (int e = 0; e < NE; ++e) {
                const LAS u32x2* wrow = (const LAS u32x2*)(wr + e * 2048) + lane; float p = 0.f;
#pragma unroll
                for (int j = 0; j < 8; ++j) { const u32x2 w2 = wrow[64 * j]; p += (v[j].x * bflo(w2.x) + v[j].y * bfhi(w2.x)) + (v[j].z * bflo(w2.y) + v[j].w * bfhi(w2.y)); }
                p = wave_sum(p); if (lane == e) lg = p + brt[e];
            }
            float tv[4]; int ti[4];
#pragma unroll
            for (int k = 0; k < 4; ++k) {
                float bv = lg; int bi = lane;
#pragma unroll
                for (int o = 1; o < 64; o <<= 1) { const float ov = __shfl_xor(bv, o); const int oi = __shfl_xor(bi, o); if (ov > bv || (ov == bv && oi < bi)) { bv = ov; bi = oi; } }
                tv[k] = bv; ti[k] = bi; if (lane == bi) lg = -3.0e38f;
            }
            const float e1 = __expf(tv[1] - tv[0]), e2 = __expf(tv[2] - tv[0]), e3 = __expf(tv[3] - tv[0]); const float inv = 1.0f / (1.0f + e1 + e2 + e3);
            if (lane < 4) { const int ee = lane == 0 ? ti[0] : lane == 1 ? ti[1] : lane == 2 ? ti[2] : ti[3]; const float gg = (lane == 0 ? 1.0f : lane == 1 ? e1 : lane == 2 ? e2 : e3) * inv;
                pick_e[lr * 4 + lane] = ee; pick_g[lr * 4 + lane] = gg; }
        }
        __syncthreads();
        if (tid < 128) pick_lp[tid] = atomicAdd((int*)&lcnt[pick_e[tid]], 1);
        __syncthreads();
        if (tid < 32) { const int n = lcnt[tid]; lbase[tid] = n ? (int)__hip_atomic_fetch_add(ctl + CW_CNT + 64 * tid, (unsigned)n, __ATOMIC_RELAXED, __HIP_MEMORY_SCOPE_AGENT) : 0; }
        __syncthreads();
        if (tid < 128) { const int e = pick_e[tid], pos = lbase[e] + pick_lp[tid], m = base + (tid >> 2);
            tok_of[e * 8192 + pos] = m; rec_e[m * 4 + (tid & 3)] = e; rec_p[m * 4 + (tid & 3)] = pos; rec_g[m * 4 + (tid & 3)] = pick_g[tid]; }
        __syncthreads();
    }
}

__device__ __forceinline__ void moe_tile_starts(const unsigned* ctl, LAS int* ts, int tid) {
    if (tid < 64) {
        const int c = (tid < NE) ? (int)__hip_atomic_load(ctl + CW_CNT + 64 * tid, __ATOMIC_RELAXED, __HIP_MEMORY_SCOPE_AGENT) : 0;
        const int nt = (c + 255) >> 8; int s = nt;
#pragma unroll
        for (int o = 1; o < 64; o <<= 1) { const int t = __shfl_up(s, o); if (tid >= o) s += t; }
        if (tid < NE) ts[tid] = s - nt;
        if (tid == NE - 1) ts[NE] = s;
    }
    __syncthreads();
}

__device__ __forceinline__ void final_phase(const Args& a, LAS unsigned char* lds, int tid, int lane, int wave, int vcu, int G) {
    unsigned char* ws = a.ws;
    LAS int* ts = (LAS int*)lds;
    moe_tile_starts((const unsigned*)(ws + WS_CTL), ts, tid);
#ifndef FINAL_MODE
#define FINAL_MODE 0
#endif
    const float* h2 = (FINAL_MODE == 1) ? (const float*)(ws + WS_H1) : (FINAL_MODE == 3) ? a.in[I_X] : (const float*)(ws + WS_H2); const float* nw = a.in[I_NORM_FINAL]; const bf16* y = (const bf16*)(ws + WS_Y);
    const int* rec_e = (const int*)(ws + WS_REC); const int* rec_p = rec_e + T * 4; const float* rec_g = (const float*)(rec_p + T * 4);
    const float* bd = a.in[I_B_DOWN];
    const int gw = vcu * NWAVES + wave, NGW = G * NWAVES;
    f32x4 wv[8];
#pragma unroll
    for (int j = 0; j < 8; ++j) wv[j] = ((const f32x4*)nw)[lane + 64 * j];
    for (int m = gw; m < T; m += NGW) {
        const f32x4* xr = (const f32x4*)(h2 + (size_t)m * D) + lane;
        f32x4 v[8];
#pragma unroll
        for (int j = 0; j < 8; ++j) v[j] = xr[64 * j];
#pragma unroll 1
        for (int k = 0; k < (FINAL_MODE ? 0 : 4); ++k) {
            const int e = rec_e[m * 4 + k], pos = rec_p[m * 4 + k]; const float gt = rec_g[m * 4 + k];
            const int slot = ts[e] * 256 + pos;
            const u32x2* yr = (const u32x2*)(y + (size_t)slot * 2048) + lane;
#pragma unroll
            for (int j = 0; j < 8; ++j) { const u32x2 w2 = yr[64 * j]; v[j].x += gt * bflo(w2.x); v[j].y += gt * bfhi(w2.x); v[j].z += gt * bflo(w2.y); v[j].w += gt * bfhi(w2.y); }
        }
        float ss = 0.f;
#pragma unroll
        for (int j = 0; j < 8; ++j) ss += (v[j].x * v[j].x + v[j].y * v[j].y) + (v[j].z * v[j].z + v[j].w * v[j].w);
        const float rstd = rsqrtf(wave_sum(ss) * (1.f / D) + EPS);
        f32x4* o = (f32x4*)(a.out + (size_t)m * D) + lane;
#pragma unroll
        for (int j = 0; j < 8; ++j) { f32x4 r = v[j] * rstd * wv[j];
#ifdef SANITIZE
            for (int q = 0; q < 4; ++q) if (!(fabsf(r[q]) < 1e30f)) r[q] = 0.f;
#endif
            o[64 * j] = r; }
    }
    (void)bd;
}

__global__ void __launch_bounds__(NTHREADS, 2) hybrid_fwd(Args args) {
    extern __shared__ __attribute__((aligned(16))) unsigned char lds_raw[];
    LAS unsigned char* lds = (LAS unsigned char*)lds_raw;
    volatile LAS unsigned* MISC = (volatile LAS unsigned*)(lds + MISC_OFF);
    const int tid = threadIdx.x, lane = tid & 63, wave = __builtin_amdgcn_readfirstlane(tid >> 6);
    const int G = gridDim.x; const int bx = blockIdx.x; const int vcu = (G % 8 == 0) ? (bx % 8) * (G / 8) + bx / 8 : bx;
    unsigned char* ws = args.ws;
    unsigned* ctl = (unsigned*)(ws + WS_CTL);
    for (int u = tid; u < (LDS_BYTES - MISC_OFF) / 4; u += NTHREADS) ((LAS unsigned*)(lds + MISC_OFF))[u] = 0u;
    __syncthreads();
    XcdBarrier bar; bar.bar = ctl + CW_BAR; bar.x = 0; bar.st = nullptr;
    if (MK_LAUNCHES == 1) bar = xcd_barrier_post(ctl + CW_BAR, MISC + 8);
    const int lo = args.ph_lo, hi = args.ph_hi;
#ifndef PHASE_MASK
#define PHASE_MASK 0x3fff
#endif
#define IN(k) ((((PHASE_MASK) >> (k)) & 1) && lo <= (k) && (k) < hi)
#define SEAM(k) do { if (IN(k) && IN((k) + 1)) xcd_barrier(bar); } while (0)

    if (IN(0)) { p0_prologue(args, lds, tid, lane, wave, vcu, G); SEAM(0); }

    if (IN(1)) {
        P1Sched S; S.G = G; S.c = bx;
        S.inproj = DenseSched{(const char*)(ws + WS_HN), (const char*)(ws + WS_WIN), (char*)(ws + WS_P), PCOLS, 32, 16, 512, G, bx};
        S.memn = (const char*)(ws + WS_MEMN); S.wk = (const char*)(ws + WS_WK); S.wv = (const char*)(ws + WS_WV); S.kmem = (char*)(ws + WS_KMEM); S.vt = (char*)(ws + WS_VT);
        pg8::EpiBf16P<0> E;
        pg8::gemm_phase<pg8::EpiBf16P<0>, P1Sched, false>(lds, S, E);
        SEAM(1);
    }
    if (IN(2)) {
        for (int u = vcu; u < 256; u += G) ssd_chunk_unit(args, lds, u, tid, lane, wave);
        for (int u = vcu; u < 256; u += G) pool_unit(args, lds, u, tid, lane, wave);
        SEAM(2);
    }
    if (IN(3)) {
        const float* st = (const float*)(ws + WS_STATES); const float* cdec = (const float*)(ws + WS_CDEC); bf16* prev = (bf16*)(ws + WS_PREV);
        for (int idx = bx * NTHREADS + tid; idx < NB * 16 * 4096; idx += G * NTHREADS) {
            const int b = idx >> 16, rem = idx & 65535, h = rem >> 12, e2 = rem & 4095;
            float h0 = 0.f, h1 = 0.f;
#pragma unroll 4
            for (int c = 0; c < NCH; ++c) {
                const size_t o = ((size_t)((b * NCH + c) * 16 + h)) * 8192 + e2 * 2;
                const f32x2 s = *(const f32x2*)(st + o); const float dc = cdec[(b * NCH + c) * 16 + h];
                *(unsigned*)(prev + o) = pk2(h0, h1);
                h0 = h0 * dc + s.x; h1 = h1 * dc + s.y;
            }
        }
        SEAM(3);
    }
    if (IN(4)) { for (int u = vcu; u < 256; u += G) ssd_combine_unit(args, lds, u, tid, lane, wave); SEAM(4); }
    if (IN(5)) {
        DenseSched S{(const char*)(ws + WS_YCAT), (const char*)(ws + WS_WOUT), nullptr, 2048, 32, 8, 256, G, bx};
        pg8::EpiF32Res E{args.in[I_X], (float*)(ws + WS_H1), 2048};
        pg8::gemm_phase<pg8::EpiF32Res, DenseSched, false>(lds, S, E);
        SEAM(5);
    }
    if (IN(6)) { rms_rows_bf16((const float*)(ws + WS_H1), args.in[I_NORM_XATTN], (bf16*)(ws + WS_HN), T, vcu * NWAVES + wave, G * NWAVES, lane); SEAM(6); }
    if (IN(7)) {
        DenseSched S{(const char*)(ws + WS_HN), (const char*)(ws + WS_WQ), (char*)(ws + WS_Q), 2048, 32, 8, 256, G, bx};
        pg8::EpiBf16P<1> E;
        pg8::gemm_phase<pg8::EpiBf16P<1>, DenseSched, false>(lds, S, E);
        SEAM(7);
    }
    if (IN(8)) { for (int u = vcu; u < 256; u += G) attn_unit(args, lds, u, tid, lane, wave); SEAM(8); }
    if (IN(9)) {
        DenseSched S{(const char*)(ws + WS_O), (const char*)(ws + WS_WO), nullptr, 2048, 32, 8, 256, G, bx};
        pg8::EpiF32Res E{(const float*)(ws + WS_H1), (float*)(ws + WS_H2), 2048};
        pg8::gemm_phase<pg8::EpiF32Res, DenseSched, false>(lds, S, E);
        SEAM(9);
    }
    if (IN(10)) { router_phase(args, lds, tid, lane, wave, vcu, G); SEAM(10); }
    if (IN(11)) {
        LAS int* ts = (LAS int*)(lds + 131072);
        moe_tile_starts(ctl, ts, tid);
        MoeSched S{ts, (const int*)(ctl + CW_CNT), (const int*)(ws + WS_TOK), (const char*)(ws + WS_HN), (const char*)(ws + WS_WGU), (char*)(ws + WS_ACT), 16, 128, G, bx, (size_t)4096 * 4096, true};
        pg8::EpiSwiglu E{args.in[I_B_GATE], args.in[I_B_UP]};
        pg8::gemm_phase<pg8::EpiSwiglu, MoeSched, true>(lds, S, E);
        SEAM(11);
    }
    if (IN(12)) {
        LAS int* ts = (LAS int*)(lds + 131072);
        moe_tile_starts(ctl, ts, tid);
        MoeSched S{ts, (const int*)(ctl + CW_CNT), (const int*)(ws + WS_TOK), (const char*)(ws + WS_ACT), (const char*)(ws + WS_WD), (char*)(ws + WS_Y), 8, 256, G, bx, (size_t)2048 * 4096, false};
        pg8::EpiBf16B E{args.in[I_B_DOWN], 2048};
        pg8::gemm_phase<pg8::EpiBf16B, MoeSched, false>(lds, S, E);
        SEAM(12);
    }
#ifdef DIAG
    if (lo <= 13 && 13 < hi) {
        unsigned flags = 0;
        const size_t gt = (size_t)bx * NTHREADS + tid, gn = (size_t)G * NTHREADS;
    }
    if (lo <= 14 && 14 < hi) {
        for (size_t i = (size_t)bx * NTHREADS + tid; i < (size_t)T * D; i += (size_t)G * NTHREADS) args.out[i] = 0.f;
        if (bx == 0 && tid == 0) args.out[0] = 1000.0f * (float)ctl[10];
    }
#else
    if (IN(13)) { final_phase(args, lds, tid, lane, wave, vcu, G); }
#endif
#undef IN
#undef SEAM
}

extern "C" void kernel_launch(void* const* d_in, const int* in_sizes, int n_in, void* d_out, int out_size, void* d_ws, size_t ws_size, hipStream_t stream) {
    static int grid = 0;
    if (grid == 0) {
        if (n_in != 28 || out_size != T * D || ws_size < WS_END) { fprintf(stderr, "kernel_launch: unexpected shapes (n_in %d, out %d, ws %zu < %zu)\n", n_in, out_size, ws_size, (size_t)WS_END); grid = -1; return; }
        int dev = 0, cus = 0, per_cu = 0;
        if (hipGetDevice(&dev) != hipSuccess || hipDeviceGetAttribute(&cus, hipDeviceAttributeMultiprocessorCount, dev) != hipSuccess) { grid = -1; return; }
        if (hipFuncSetAttribute((const void*)hybrid_fwd, hipFuncAttributeMaxDynamicSharedMemorySize, LDS_BYTES) != hipSuccess) { fprintf(stderr, "kernel_launch: hipFuncSetAttribute failed\n"); grid = -1; return; }
        if (hipOccupancyMaxActiveBlocksPerMultiprocessor(&per_cu, (const void*)hybrid_fwd, NTHREADS, LDS_BYTES) != hipSuccess || per_cu < 1)
            fprintf(stderr, "kernel_launch: occupancy query reports %d workgroups per CU\n", per_cu);
        (void)hipGetLastError();
        grid = cus;
    }
    if (grid < 0) return;
    if (hipMemsetAsync((char*)d_ws + WS_CTL, 0, CTL_ZERO_BYTES, stream) != hipSuccess) return;
    Args a{};
    for (int i = 0; i < 28; ++i) a.in[i] = (const float*)d_in[i];
    a.out = (float*)d_out; a.ws = (unsigned char*)d_ws; a.pad = 0;
    for (int li = 0; li < MK_LAUNCHES; ++li) {
        a.ph_lo = (MK_LAUNCHES == 1) ? 0 : li; a.ph_hi = (MK_LAUNCHES == 1) ? NPHASE + 1 : li + 1; a.li = li;
        hipLaunchKernelGGL(hybrid_fwd, dim3(grid), dim3(NTHREADS), LDS_BYTES, stream, a);
        const hipError_t le = hipPeekAtLastError();
        if (le != hipSuccess) { fprintf(stderr, "kernel_launch: launch %d failed: %s\n", li, hipGetErrorName(le)); break; }
    }
}
```

```cpp
#include <hip/hip_runtime.h>
#include <cstdio>
#include <cstdint>

#ifndef MK_LAUNCHES
#define MK_LAUNCHES 1
#endif

#define GAS __attribute__((address_space(1)))
#define LAS __attribute__((address_space(3)))
typedef unsigned short bf16;
typedef short bf16x8 __attribute__((ext_vector_type(8)));
typedef float f32x4 __attribute__((ext_vector_type(4)));
typedef float f32x2 __attribute__((ext_vector_type(2)));
typedef unsigned u32x4 __attribute__((ext_vector_type(4)));
typedef unsigned u32x2 __attribute__((ext_vector_type(2)));

constexpr int NB = 2, SEQ = 4096, T = NB * SEQ, D = 2048;
constexpr int DSSD = 1024, HEADS = 16, HD = 64, GROUPS = 4, NST = 128, CHUNK = 128, NCH = SEQ / CHUNK;
constexpr int DIN = 4112, PCOLS = 4096;
constexpr int DCONV = 2048;
constexpr int NMEM = 256, XH = 4, XHD = 512;
constexpr int NE = 32, TOPK = 4;
constexpr int SLOT_CAP = 41216;
constexpr float EPS = 1e-5f;
constexpr int NTHREADS = 512, NWAVES = 8;
constexpr int NPHASE = 14;

constexpr size_t MiB = 1u << 20;
constexpr size_t WS_CTL = 0, CTL_ZERO_BYTES = 1 * MiB;
constexpr size_t WS_WIN = 1 * MiB;
constexpr size_t WS_WOUT = WS_WIN + 16 * MiB;
constexpr size_t WS_WQ = WS_WOUT + 8 * MiB;
constexpr size_t WS_WK = WS_WQ + 8 * MiB;
constexpr size_t WS_WV = WS_WK + 8 * MiB;
constexpr size_t WS_WO = WS_WV + 8 * MiB;
constexpr size_t WS_PW = WS_WO + 8 * MiB;
constexpr size_t WS_WR = WS_PW + 1 * MiB;
constexpr size_t WS_WGU = WS_WR + 1 * MiB;
constexpr size_t WS_WD = WS_WGU + 512 * MiB;
constexpr size_t WS_HN = WS_WD + 256 * MiB;
constexpr size_t WS_MEMN = WS_HN + 32 * MiB;
constexpr size_t WS_P = WS_MEMN + 2 * MiB;
constexpr size_t WS_DTRAW = WS_P + 64 * MiB;
constexpr size_t WS_ACS = WS_DTRAW + 1 * MiB;
constexpr size_t WS_CDEC = WS_ACS + 1 * MiB;
constexpr size_t WS_KMEM = WS_CDEC + 1 * MiB;
constexpr size_t WS_VT = WS_KMEM + 2 * MiB;
constexpr size_t WS_XS = WS_VT + 2 * MiB;
constexpr size_t WS_CMG = WS_XS + 16 * MiB;
constexpr size_t WS_YDIAG = WS_CMG + 8 * MiB;
constexpr size_t WS_STATES = WS_YDIAG + 32 * MiB;
constexpr size_t WS_PREV = WS_STATES + 32 * MiB;
constexpr size_t WS_YCAT = WS_PREV + 16 * MiB;
constexpr size_t WS_H1 = WS_YCAT + 32 * MiB;
constexpr size_t WS_H2 = WS_H1 + 64 * MiB;
constexpr size_t WS_Q = WS_H2 + 64 * MiB;
constexpr size_t WS_O = WS_Q + 32 * MiB;
constexpr size_t WS_TOK = WS_O + 32 * MiB;
constexpr size_t WS_REC = WS_TOK + 1 * MiB;
constexpr size_t WS_ACT = WS_REC + 1 * MiB;
constexpr size_t WS_Y = WS_ACT + 162 * MiB;
constexpr size_t WS_END = WS_Y + 162 * MiB;
static_assert((size_t)SLOT_CAP * 2048 * 2 <= 162 * MiB, "act");

constexpr int CW_BAR = 4096;
constexpr int CW_CNT = 16384;

constexpr int LDS_BYTES = 147456;
constexpr int MISC_OFF = 146944;

#define LDS_WAIT() asm volatile("s_waitcnt lgkmcnt(0)" ::: "memory")
#define VM_WAIT() asm volatile("s_waitcnt vmcnt(0)" ::: "memory")

__device__ __forceinline__ unsigned f2bf(float f) { unsigned u = __builtin_bit_cast(unsigned, f); return (u + 0x7fffu + ((u >> 16) & 1u)) >> 16; }
typedef __bf16 bf16x2_t __attribute__((ext_vector_type(2)));
__device__ __forceinline__ unsigned pk2(float lo, float hi) { const f32x2 v = {lo, hi}; const bf16x2_t b = __builtin_convertvector(v, bf16x2_t); return __builtin_bit_cast(unsigned, b); }
__device__ __forceinline__ float bf2f(unsigned b) { return __builtin_bit_cast(float, b << 16); }
__device__ __forceinline__ float bflo(unsigned w) { return __builtin_bit_cast(float, w << 16); }
__device__ __forceinline__ float bfhi(unsigned w) { return __builtin_bit_cast(float, w & 0xffff0000u); }
__device__ __forceinline__ float wave_sum(float v) {
#pragma unroll
    for (int o = 1; o < 64; o <<= 1) v += __shfl_xor(v, o);
    return v;
}
__device__ __forceinline__ float siluf(float x) { return x / (1.0f + __expf(-x)); }

namespace pg8 {
constexpr int BM = 256, BK = 64, HALF = 128, HTB = HALF * BK * 2, STAGE_BYTES = 8 * HTB, KD = 2048;
__host__ __device__ __forceinline__ int lds_byte(int r, int c) { const int st = (r >> 4) * 2 + (c >> 5), rr = r & 15, cc = c & 31, ob = rr * 64 + cc * 2; return st * 1024 + (ob ^ (((ob >> 9) & 1) << 5)); }
__host__ __device__ __forceinline__ void stage_rc(int b, int& R, int& C) { const int st = b / 1024, sb = b % 1024, swz = sb ^ (((sb >> 9) & 1) << 5); R = (st >> 1) * 16 + swz / 64; C = (st & 1) * 32 + (swz % 64) / 2; }
__host__ __device__ __forceinline__ int perm32(int rho) { const int n = rho >> 4, i = rho & 15; return 8 * (i >> 2) + 4 * n + (i & 3); }

struct Unit { const char* A; const char* B; char* O; const int* tok; int ldc, row0, col0, e, cnt; };

template <int SC> struct EpiBf16P {
    static constexpr bool PERM = true;
    __device__ __forceinline__ void operator()(const f32x4 (&acc)[2][2][4][2], const Unit& u, int wr, int wc, int fr, int fq) const {
        const float scale = SC ? 0.04419417382415922f : 1.0f;
        const int rowt = wr * 64 + fr, colt = wc * 32 + 8 * fq;
        bf16* base = (bf16*)u.O;
#pragma unroll
        for (int ai = 0; ai < 2; ++ai)
#pragma unroll
            for (int m = 0; m < 4; ++m) { bf16* rowp = base + (size_t)(u.row0 + rowt + ai * HALF + m * 16) * u.ldc + u.col0 + colt;
#pragma unroll
                for (int bj = 0; bj < 2; ++bj) { const f32x4 v0 = acc[ai][bj][m][0] * scale, v1 = acc[ai][bj][m][1] * scale;
                    u32x4 w; w.x = pk2(v0[0], v0[1]); w.y = pk2(v0[2], v0[3]); w.z = pk2(v1[0], v1[1]); w.w = pk2(v1[2], v1[3]);
                    *(u32x4*)(rowp + bj * HALF) = w; } }
    }
};
struct EpiBf16B {
    static constexpr bool PERM = true;
    const float* bias; int bias_stride;
    __device__ __forceinline__ void operator()(const f32x4 (&acc)[2][2][4][2], const Unit& u, int wr, int wc, int fr, int fq) const {
        const int rowt = wr * 64 + fr, colt = wc * 32 + 8 * fq;
        bf16* base = (bf16*)u.O;
        f32x4 bv[2][2];
#pragma unroll
        for (int bj = 0; bj < 2; ++bj)
#pragma unroll
            for (int n = 0; n < 2; ++n) bv[bj][n] = *(const f32x4*)(bias + (size_t)u.e * bias_stride + u.col0 + colt + bj * HALF + 4 * n);
#pragma unroll
        for (int ai = 0; ai < 2; ++ai)
#pragma unroll
            for (int m = 0; m < 4; ++m) { bf16* rowp = base + (size_t)(u.row0 + rowt + ai * HALF + m * 16) * u.ldc + u.col0 + colt;
#pragma unroll
                for (int bj = 0; bj < 2; ++bj) { const f32x4 v0 = acc[ai][bj][m][0] + bv[bj][0], v1 = acc[ai][bj][m][1] + bv[bj][1];
                    u32x4 w; w.x = pk2(v0[0], v0[1]); w.y = pk2(v0[2], v0[3]); w.z = pk2(v1[0], v1[1]); w.w = pk2(v1[2], v1[3]);
                    *(u32x4*)(rowp + bj * HALF) = w; } }
    }
};
struct EpiF32Res {
    static constexpr bool PERM = false;
    const float* base; float* out; int ldc;
    __device__ __forceinline__ void operator()(const f32x4 (&acc)[2][2][4][2], const Unit& u, int wr, int wc, int fr, int fq) const {
        const int row0 = u.row0 + wr * 64 + fr, col0 = u.col0 + wc * 32 + 4 * fq;
#pragma unroll
        for (int ai = 0; ai < 2; ++ai)
#pragma unroll
            for (int m = 0; m < 4; ++m) { const size_t off = (size_t)(row0 + ai * HALF + m * 16) * ldc + col0;
#pragma unroll
                for (int bj = 0; bj < 2; ++bj)
#pragma unroll
                    for (int n = 0; n < 2; ++n) { const f32x4 bs = *(const f32x4*)(base + off + bj * HALF + n * 16); *(f32x4*)(out + off + bj * HALF + n * 16) = bs + acc[ai][bj][m][n]; } }
    }
};
struct EpiSwiglu {
    static constexpr bool PERM = true;
    const float* bg; const float* bu;
    __device__ __forceinline__ void operator()(const f32x4 (&acc)[2][2][4][2], const Unit& u, int wr, int wc, int fr, int fq) const {
        const int rowt = wr * 64 + fr, colt = u.col0 + wc * 32 + 8 * fq;
        bf16* base = (bf16*)u.O;
        f32x4 g_[2], u_[2];
#pragma unroll
        for (int n = 0; n < 2; ++n) { g_[n] = *(const f32x4*)(bg + (size_t)u.e * 2048 + colt + 4 * n); u_[n] = *(const f32x4*)(bu + (size_t)u.e * 2048 + colt + 4 * n); }
#pragma unroll
        for (int ai = 0; ai < 2; ++ai)
#pragma unroll
            for (int m = 0; m < 4; ++m) { bf16* rowp = base + (size_t)(u.row0 + rowt + ai * HALF + m * 16) * 2048 + colt;
                float a[8];
#pragma unroll
                for (int n = 0; n < 2; ++n)
#pragma unroll
                    for (int j = 0; j < 4; ++j) { float g = acc[ai][0][m][n][j] + g_[n][j], up = acc[ai][1][m][n][j] + u_[n][j];
                        g = fminf(g, 7.0f); up = fminf(fmaxf(up, -7.0f), 7.0f);
                        a[n * 4 + j] = g * __builtin_amdgcn_rcpf(1.0f + __expf(-1.702f * g)) * (up + 1.0f); }
                u32x4 w; w.x = pk2(a[0], a[1]); w.y = pk2(a[2], a[3]); w.z = pk2(a[4], a[5]); w.w = pk2(a[6], a[7]);
                *(u32x4*)rowp = w; }
    }
};

template <class Epi, class Sched, bool GATHER>
__device__ __forceinline__ void gemm_phase(LAS unsigned char* lds, const Sched& S, const Epi& E) {
    const int tid = threadIdx.x, wid = __builtin_amdgcn_readfirstlane(tid >> 6), lane = tid & 63, wr = wid >> 2, wc = wid & 3, fr = lane & 15, fq = lane >> 4;
    constexpr int K = KD, nt = K / BK;
    unsigned voffA[2][2], voffB[2];
#pragma unroll
    for (int i = 0; i < 2; ++i) { int R, C; stage_rc(tid * 16 + i * 8192, R, C); const int Rb = Epi::PERM ? ((R & ~31) + perm32(R & 31)) : R;
        voffA[0][i] = (unsigned)(R * K + C) * 2u; voffA[1][i] = (unsigned)((R + HALF) * K + C) * 2u; voffB[i] = (unsigned)(Rb * K + C) * 2u; }
    constexpr size_t kstep = (size_t)(BK * 2);
    constexpr size_t hstep = (size_t)HALF * K * 2;
    const unsigned ldsw = (unsigned)wid * 1024u;
    const int aoff = lds_byte(wr * 64 + fr, fq * 8), boff = lds_byte(wc * 32 + fr, fq * 8);
#define PG8_SA(b, h) (((b) * 2 + (h)) * HTB)
#define PG8_SB(b, h) ((4 + (b) * 2 + (h)) * HTB)
#define PG8_STAGE(bufoff, gbase, voff) do { _Pragma("unroll") for (int _i = 0; _i < 2; ++_i) \
        __builtin_amdgcn_global_load_lds((const unsigned*)((const char*)(gbase) + (voff)[_i]), (LAS unsigned*)(lds + (bufoff) + ldsw + _i * 8192), 16, 0, 0); } while (0)
#define PG8_LDA(dst, b, h) do { _Pragma("unroll") for (int m = 0; m < 4; ++m) _Pragma("unroll") for (int k = 0; k < 2; ++k) dst[m][k] = *(const LAS bf16x8*)(lds + PG8_SA(b, h) + aoff + m * 2048 + k * 1024); } while (0)
#define PG8_LDB(dst, b, h) do { _Pragma("unroll") for (int n = 0; n < 2; ++n) _Pragma("unroll") for (int k = 0; k < 2; ++k) dst[n][k] = *(const LAS bf16x8*)(lds + PG8_SB(b, h) + boff + n * 2048 + k * 1024); } while (0)
#define PG8_MMA(ai, bj, At, Bt) do { __builtin_amdgcn_s_setprio(1); _Pragma("unroll") for (int m = 0; m < 4; ++m) _Pragma("unroll") for (int n = 0; n < 2; ++n) _Pragma("unroll") for (int k = 0; k < 2; ++k) \
        acc[ai][bj][m][n] = __builtin_amdgcn_mfma_f32_16x16x32_bf16(Bt[n][k], At[m][k], acc[ai][bj][m][n], 0, 0, 0); __builtin_amdgcn_s_setprio(0); } while (0)
#define PG8_WAIT_V(n) asm volatile("s_waitcnt vmcnt(" #n ")" ::: "memory")
#define PG8_WAIT_L(n) asm volatile("s_waitcnt lgkmcnt(" #n ")" ::: "memory")
#define PG8_BAR __builtin_amdgcn_s_barrier()
#define PG8_SCHED __builtin_amdgcn_sched_barrier(0)
#define PG8_GATHER(dst, u) do { _Pragma("unroll") for (int _i = 0; _i < 2; ++_i) { int _R, _C; stage_rc(tid * 16 + _i * 8192, _R, _C); _Pragma("unroll") for (int _h = 0; _h < 2; ++_h) { const int _idx = _h * HALF + _R; \
        const int _t = (_idx < (u).cnt) ? (u).tok[_idx] : 0; dst[_h][_i] = (unsigned)(_t * K + _C) * 2u; } } } while (0)
    Unit cur, nxt; int ui = 0;
    if (!S.next(0, cur)) return;
    f32x4 acc[2][2][4][2];
#pragma unroll
    for (int a = 0; a < 2; ++a)
#pragma unroll
        for (int b = 0; b < 2; ++b)
#pragma unroll
            for (int m = 0; m < 4; ++m)
#pragma unroll
                for (int n = 0; n < 2; ++n) acc[a][b][m][n] = (f32x4){0.f, 0.f, 0.f, 0.f};
    bf16x8 At[4][2], B0[2][2], B1[2][2];
    const char* cA = cur.A; const char* cB = cur.B;
    if constexpr (GATHER) { PG8_GATHER(voffA, cur); }
    PG8_STAGE(PG8_SB(0, 0), cB, voffB); PG8_STAGE(PG8_SB(0, 1), cB + hstep, voffB); PG8_STAGE(PG8_SA(0, 0), cA, voffA[0]); PG8_STAGE(PG8_SA(0, 1), cA, voffA[1]);
    if (wr == 1) PG8_BAR;
    PG8_WAIT_V(2); PG8_BAR;
    PG8_STAGE(PG8_SB(1, 0), cB + kstep, voffB); PG8_STAGE(PG8_SA(1, 0), cA + kstep, voffA[0]); PG8_STAGE(PG8_SB(1, 1), cB + hstep + kstep, voffB);
    PG8_WAIT_V(6); PG8_BAR;
    for (;;) {
        const bool has_next = S.next(ui + 1, nxt);
        const char* nA = has_next ? nxt.A : cA; const char* nB = has_next ? nxt.B : cB;
        for (int t = 0; t < nt; t += 2) {
            const bool last = (t == nt - 2);
            const char* a1 = cA + (size_t)(t + 1) * kstep;
            const char* a2 = last ? nA : cA + (size_t)(t + 2) * kstep; const char* b2 = last ? nB : cB + (size_t)(t + 2) * kstep;
            const char* a3 = a2 + kstep; const char* b3 = b2 + kstep;
            PG8_LDB(B0, 0, 0); PG8_LDB(B1, 0, 1); PG8_SCHED; PG8_LDA(At, 0, 0); PG8_STAGE(PG8_SA(1, 1), a1, voffA[1]);
            PG8_WAIT_V(8); PG8_WAIT_L(0); PG8_BAR; PG8_MMA(0, 0, At, B0); PG8_MMA(0, 1, At, B1); PG8_BAR; PG8_SCHED;
            if constexpr (GATHER) { if (last && has_next) { PG8_GATHER(voffA, nxt); } }
            PG8_LDA(At, 0, 1); PG8_STAGE(PG8_SB(0, 0), b2, voffB); PG8_STAGE(PG8_SB(0, 1), b2 + hstep, voffB); PG8_STAGE(PG8_SA(0, 0), a2, voffA[0]);
            PG8_WAIT_V(8); PG8_WAIT_L(0); PG8_BAR; PG8_MMA(1, 0, At, B0); PG8_MMA(1, 1, At, B1); PG8_BAR; PG8_SCHED;
            PG8_LDB(B0, 1, 0); PG8_LDB(B1, 1, 1); PG8_SCHED; PG8_LDA(At, 1, 0); PG8_STAGE(PG8_SA(0, 1), a2, voffA[1]);
            PG8_WAIT_V(8); PG8_WAIT_L(0); PG8_BAR; PG8_MMA(0, 0, At, B0); PG8_MMA(0, 1, At, B1); PG8_BAR; PG8_SCHED;
            PG8_LDA(At, 1, 1); PG8_STAGE(PG8_SB(1, 0), b3, voffB); PG8_STAGE(PG8_SB(1, 1), b3 + hstep, voffB); PG8_STAGE(PG8_SA(1, 0), a3, voffA[0]);
            PG8_WAIT_V(8); PG8_WAIT_L(0); PG8_BAR; PG8_MMA(1, 0, At, B0); PG8_MMA(1, 1, At, B1); PG8_BAR; PG8_SCHED;
        }
        if (wr == 0) PG8_BAR;
        E(acc, cur, wr, wc, fr, fq);
        if (!has_next) break;
#pragma unroll
        for (int a = 0; a < 2; ++a)
#pragma unroll
            for (int b = 0; b < 2; ++b)
#pragma unroll
                for (int m = 0; m < 4; ++m)
#pragma unroll
                    for (int n = 0; n < 2; ++n) acc[a][b][m][n] = (f32x4){0.f, 0.f, 0.f, 0.f};
        cur = nxt; cA = nA; cB = nB; ++ui;
        if (wr == 1) PG8_BAR;
    }
    PG8_WAIT_V(0);
    PG8_BAR;
#undef PG8_SA
#undef PG8_SB
#undef PG8_STAGE
#undef PG8_LDA
#undef PG8_LDB
#undef PG8_MMA
#undef PG8_WAIT_V
#undef PG8_WAIT_L
#undef PG8_BAR
#undef PG8_SCHED
#undef PG8_GATHER
}
}

#define XB_TMO      128
#define XB_XCNT(j)  (256  + 64 * (j))
#define XB_XSUB(j)  (1280 + 64 * (j))
#define XB_XGEN(j)  (2304 + 64 * (j))
#define XB_TOP      3328
#define XB_TOPGEN   3392
#define XCD_BAR_WORDS 3456
#define XB_SPIN_CAP (1u << 18)
__device__ __forceinline__ unsigned xb_ld(unsigned* p)              { return __hip_atomic_load(p, __ATOMIC_RELAXED, __HIP_MEMORY_SCOPE_AGENT); }
__device__ __forceinline__ unsigned xb_add(unsigned* p, unsigned v) { return __hip_atomic_fetch_add(p, v, __ATOMIC_RELAXED, __HIP_MEMORY_SCOPE_AGENT); }
__device__ __forceinline__ unsigned xb_xcc_id() { return (unsigned)__builtin_amdgcn_s_getreg((3 << 11) | 20) & 0xFu; }
#define XB_SPIN(cond, bar) do { unsigned _sp = 0; while (cond) { __builtin_amdgcn_s_sleep(1); \
    if ((++_sp & 255u) == 0u) { if (xb_ld(&(bar)[XB_TMO])) break; if (_sp > XB_SPIN_CAP) { atomicAdd(&(bar)[XB_TMO], 1u); break; } } } } while (0)
struct XcdBarrier { unsigned* bar; unsigned x; volatile LAS unsigned* st; };
__device__ __forceinline__ XcdBarrier xcd_barrier_post(unsigned* bar, volatile LAS unsigned* st) {
    XcdBarrier b; b.bar = bar; b.x = xb_xcc_id(); b.st = st;
    if (threadIdx.x == 0) (void)xb_add(&bar[XB_XCNT(b.x)], 1u);
    return b;
}
__device__ __forceinline__ void xcd_barrier_complete(unsigned* bar, unsigned x, unsigned& nloc, unsigned& nx) {
    const unsigned G = gridDim.x * gridDim.y * gridDim.z;
    unsigned sum, cnt, mine, sp = 0u;
    for (;;) {
        sum = 0u; cnt = 0u; mine = 0u;
#pragma unroll
        for (unsigned j = 0; j < 16; ++j) { const unsigned c = xb_ld(&bar[XB_XCNT(j)]); sum += c; cnt += (c > 0u) ? 1u : 0u; mine = (j == x) ? c : mine; }
        if (sum == G) break;
        __builtin_amdgcn_s_sleep(1);
        if ((++sp & 255u) == 0u) { if (xb_ld(&bar[XB_TMO])) break; if (sp > XB_SPIN_CAP) { atomicAdd(&bar[XB_TMO], 1u); break; } }
    }
    nloc = mine > 0u ? mine : 1u; nx = cnt > 0u ? cnt : 1u;
}
__device__ __forceinline__ void xcd_barrier(const XcdBarrier& b) {
    asm volatile("s_waitcnt vmcnt(0)" ::: "memory");
    __syncthreads();
    if (threadIdx.x == 0) {
        unsigned* bar = b.bar;
        __builtin_amdgcn_s_waitcnt(0);
        unsigned nloc = b.st[0], nx = b.st[1];
        if (nloc == 0u) { xcd_barrier_complete(bar, b.x, nloc, nx); b.st[0] = nloc; b.st[1] = nx; }
        const unsigned old = xb_add(&bar[XB_XSUB(b.x)], 1u);
        const unsigned gen = old / nloc;
        if (old + 1u == (gen + 1u) * nloc) {
            __builtin_amdgcn_fence(__ATOMIC_RELEASE, "agent");
            asm volatile("s_waitcnt vmcnt(0)" ::: "memory");
            const unsigned og = xb_add(&bar[XB_TOP], 1u);
            const unsigned tg = og / nx;
            if (og + 1u == (tg + 1u) * nx) xb_add(&bar[XB_TOPGEN], 1u);
            else XB_SPIN(xb_ld(&bar[XB_TOPGEN]) == tg, bar);
            __builtin_amdgcn_fence(__ATOMIC_ACQUIRE, "agent");
            xb_add(&bar[XB_XGEN(b.x)], 1u);
            asm volatile("s_waitcnt vmcnt(0)" ::: "memory");
        } else {
            XB_SPIN(xb_ld(&bar[XB_XGEN(b.x)]) == gen, bar);
            __builtin_amdgcn_fence(__ATOMIC_ACQUIRE, "agent");
            asm volatile("s_waitcnt vmcnt(0)" ::: "memory");
        }
    }
    __syncthreads();
}

struct Args {
    const float* in[28];
    float* out; unsigned char* ws;
    int ph_lo, ph_hi, li, pad;
};
enum { I_X = 0, I_MEM, I_NORM_MIX, I_W_IN, I_CONV_W, I_CONV_B, I_DT_BIAS, I_A_LOG, I_D_SKIP, I_SSD_NORM, I_POOL_W, I_POOL_SCALE, I_W_OUT, I_NORM_XATTN, I_NORM_MEM,
       I_W_Q, I_W_KV, I_W_O, I_NORM_FFN, I_W_ROUTER, I_B_ROUTER, I_W_GATE, I_B_GATE, I_W_UP, I_B_UP, I_W_DOWN, I_B_DOWN, I_NORM_FINAL };

template <int MT, int NT>
__device__ __forceinline__ void wave_mma(f32x4 (&acc)[MT][NT], const LAS bf16* A, int lda, const LAS bf16* Bt, int ldb, int K, int lane) {
    const int fr = lane & 15, fq = lane >> 4;
    for (int k0 = 0; k0 < K; k0 += 32) {
        bf16x8 a[MT], b[NT];
#pragma unroll
        for (int m = 0; m < MT; ++m) a[m] = *(const LAS bf16x8*)(A + (m * 16 + fr) * lda + k0 + fq * 8);
#pragma unroll
        for (int n = 0; n < NT; ++n) b[n] = *(const LAS bf16x8*)(Bt + (n * 16 + fr) * ldb + k0 + fq * 8);
#pragma unroll
        for (int m = 0; m < MT; ++m)
#pragma unroll
            for (int n = 0; n < NT; ++n) acc[m][n] = __builtin_amdgcn_mfma_f32_16x16x32_bf16(b[n], a[m], acc[m][n], 0, 0, 0);
    }
}
__device__ __forceinline__ void tile_g2l(LAS bf16* dst, int ldd, const bf16* src, size_t lds_, int rows, int cols, int tid) {
    const int vpr = cols >> 3, nv = rows * vpr;
    for (int i = tid; i < nv; i += NTHREADS) { const int r = i / vpr, c = i - r * vpr; *(LAS u32x4*)(dst + r * ldd + c * 8) = *(const u32x4*)(src + (size_t)r * lds_ + c * 8); }
}

__device__ __forceinline__ void transpose_block(const float* W, int ldw, int k0, bf16* dstrow, int Kd, int lane, int nvalid) {
    if (lane < nvalid) {
        const float* s = W + (size_t)k0 * ldw + lane;
        float v[64];
#pragma unroll
        for (int i = 0; i < 64; ++i) v[i] = s[(size_t)i * ldw];
        bf16* d = dstrow + (size_t)lane * Kd + k0;
#pragma unroll
        for (int j = 0; j < 8; ++j) { u32x4 o; o.x = pk2(v[8 * j], v[8 * j + 1]); o.y = pk2(v[8 * j + 2], v[8 * j + 3]); o.z = pk2(v[8 * j + 4], v[8 * j + 5]); o.w = pk2(v[8 * j + 6], v[8 * j + 7]);
            *(u32x4*)(d + 8 * j) = o; }
    }
}
struct ConvDesc { const float* src; bf16* dst; int ldw, K, srccol0, ncb, nexp, mode; size_t src_es, dst_es; };

__device__ __forceinline__ void conv_matrix(const ConvDesc& d, int gw, int NGW, int lane) {
    const int nkb = d.K / 64, per = nkb * d.ncb, total = per * d.nexp;
    for (int it = gw; it < total; it += NGW) {
        const int e = it / per, r = it - e * per, kb = r / d.ncb, nb = r - kb * d.ncb;
        const int n0 = nb * 64;
        int drow = n0;
        if (d.mode) drow = (n0 >> 7) * 256 + (n0 & 127) + (d.mode == 2 ? 128 : 0);
        transpose_block(d.src + (size_t)e * d.src_es + d.srccol0 + n0, d.ldw, kb * 64, d.dst + (size_t)e * d.dst_es + (size_t)drow * d.K, d.K, lane, 64);
    }
}

__device__ __forceinline__ void p0_prologue(const Args& a, LAS unsigned char* lds, int tid, int lane, int wave, int vcu, int G) {
    unsigned char* ws = a.ws;
    const int gw = vcu * NWAVES + wave, NGW = G * NWAVES;
    {
        ConvDesc d;
        d = ConvDesc{a.in[I_W_IN], (bf16*)(ws + WS_WIN), DIN, 2048, 0, 48, 1, 0, 0, 0}; conv_matrix(d, gw, NGW, lane);
        d = ConvDesc{a.in[I_W_IN], (bf16*)(ws + WS_WIN) + (size_t)3072 * 2048, DIN, 2048, 3088, 16, 1, 0, 0, 0}; conv_matrix(d, gw, NGW, lane);
        d = ConvDesc{a.in[I_W_OUT], (bf16*)(ws + WS_WOUT), 2048, 2048, 0, 32, 1, 0, 0, 0}; conv_matrix(d, gw, NGW, lane);
        d = ConvDesc{a.in[I_W_Q], (bf16*)(ws + WS_WQ), 2048, 2048, 0, 32, 1, 0, 0, 0}; conv_matrix(d, gw, NGW, lane);
        d = ConvDesc{a.in[I_W_KV], (bf16*)(ws + WS_WK), 4096, 2048, 0, 32, 1, 0, 0, 0}; conv_matrix(d, gw, NGW, lane);
        d = ConvDesc{a.in[I_W_KV], (bf16*)(ws + WS_WV), 4096, 2048, 2048, 32, 1, 0, 0, 0}; conv_matrix(d, gw, NGW, lane);
        d = ConvDesc{a.in[I_W_O], (bf16*)(ws + WS_WO), 2048, 2048, 0, 32, 1, 0, 0, 0}; conv_matrix(d, gw, NGW, lane);
        d = ConvDesc{a.in[I_POOL_W], (bf16*)(ws + WS_PW), 256, 256, 0, 4, 4, 0, (size_t)256 * 256, (size_t)256 * 256}; conv_matrix(d, gw, NGW, lane);
        d = ConvDesc{a.in[I_W_GATE], (bf16*)(ws + WS_WGU), 2048, 2048, 0, 32, NE, 1, (size_t)2048 * 2048, (size_t)4096 * 2048}; conv_matrix(d, gw, NGW, lane);
        d = ConvDesc{a.in[I_W_UP], (bf16*)(ws + WS_WGU), 2048, 2048, 0, 32, NE, 2, (size_t)2048 * 2048, (size_t)4096 * 2048}; conv_matrix(d, gw, NGW, lane);
        d = ConvDesc{a.in[I_W_DOWN], (bf16*)(ws + WS_WD), 2048, 2048, 0, 32, NE, 0, (size_t)2048 * 2048, (size_t)2048 * 2048}; conv_matrix(d, gw, NGW, lane);
        for (int kb = gw; kb < 32; kb += NGW) transpose_block(a.in[I_W_ROUTER], 32, kb * 64, (bf16*)(ws + WS_WR), 2048, lane, 32);
    }
    constexpr int WP = 2052;
    LAS float* wdt = (LAS float*)lds;
    {
        const float* w_in = a.in[I_W_IN];
        for (int i = tid; i < 2048 * 16; i += NTHREADS) { const int k = i >> 4, h = i & 15; wdt[h * WP + k] = w_in[(size_t)k * DIN + 3072 + h]; }
    }
    __syncthreads();
    {
        const float* x = a.in[I_X]; const float* nw = a.in[I_NORM_MIX];
        bf16* hn = (bf16*)(ws + WS_HN); float* dtraw = (float*)(ws + WS_DTRAW);
        f32x4 wv[8];
#pragma unroll
        for (int j = 0; j < 8; ++j) wv[j] = ((const f32x4*)nw)[lane + 64 * j];
        for (int m = gw; m < T; m += NGW) {
            const f32x4* xr = (const f32x4*)(x + (size_t)m * D) + lane;
            f32x4 v[8]; float ss = 0.f;
#pragma unroll
            for (int j = 0; j < 8; ++j) { v[j] = xr[64 * j]; ss += (v[j].x * v[j].x + v[j].y * v[j].y) + (v[j].z * v[j].z + v[j].w * v[j].w); }
            const float rstd = rsqrtf(wave_sum(ss) * (1.f / D) + EPS);
            u32x2* o8 = (u32x2*)(hn + (size_t)m * D) + lane;
#pragma unroll
            for (int j = 0; j < 8; ++j) { v[j] = v[j] * rstd * wv[j]; u32x2 w; w.x = pk2(v[j].x, v[j].y); w.y = pk2(v[j].z, v[j].w); o8[64 * j] = w; }
            float res = 0.f;
#pragma unroll 1
            for (int h = 0; h < 16; ++h) {
                const LAS f32x4* wr = (const LAS f32x4*)(wdt + h * WP) + lane; float p = 0.f;
#pragma unroll
                for (int j = 0; j < 8; ++j) { const f32x4 w4 = wr[64 * j]; p += (v[j].x * w4.x + v[j].y * w4.y) + (v[j].z * w4.z + v[j].w * w4.w); }
                p = wave_sum(p); if (lane == h) res = p;
            }
            if (lane < 16) dtraw[(size_t)m * 16 + lane] = res;
        }
    }
    {
        const float* x = a.in[I_MEM]; const float* nw = a.in[I_NORM_MEM]; bf16* o = (bf16*)(ws + WS_MEMN);
        for (int m = gw; m < NB * NMEM; m += NGW) {
            const f32x4* xr = (const f32x4*)(x + (size_t)m * D) + lane;
            f32x4 v[8]; float ss = 0.f;
#pragma unroll
            for (int j = 0; j < 8; ++j) { v[j] = xr[64 * j]; ss += (v[j].x * v[j].x + v[j].y * v[j].y) + (v[j].z * v[j].z + v[j].w * v[j].w); }
            const float rstd = rsqrtf(wave_sum(ss) * (1.f / D) + EPS);
            u32x2* o8 = (u32x2*)(o + (size_t)m * D) + lane;
#pragma unroll
            for (int j = 0; j < 8; ++j) { const f32x4 w4 = ((const f32x4*)nw)[lane + 64 * j]; v[j] = v[j] * rstd * w4; u32x2 w; w.x = pk2(v[j].x, v[j].y); w.y = pk2(v[j].z, v[j].w); o8[64 * j] = w; }
        }
    }
}

__device__ __forceinline__ void rms_rows_bf16(const float* src, const float* nw, bf16* o, int rows, int gw, int NGW, int lane) {
    f32x4 wv[8];
#pragma unroll
    for (int j = 0; j < 8; ++j) wv[j] = ((const f32x4*)nw)[lane + 64 * j];
    for (int m = gw; m < rows; m += NGW) {
        const f32x4* xr = (const f32x4*)(src + (size_t)m * D) + lane;
        f32x4 v[8]; float ss = 0.f;
#pragma unroll
        for (int j = 0; j < 8; ++j) { v[j] = xr[64 * j]; ss += (v[j].x * v[j].x + v[j].y * v[j].y) + (v[j].z * v[j].z + v[j].w * v[j].w); }
        const float rstd = rsqrtf(wave_sum(ss) * (1.f / D) + EPS);
        u32x2* o8 = (u32x2*)(o + (size_t)m * D) + lane;
#pragma unroll
        for (int j = 0; j < 8; ++j) { v[j] = v[j] * rstd * wv[j]; u32x2 w; w.x = pk2(v[j].x, v[j].y); w.y = pk2(v[j].z, v[j].w); o8[64 * j] = w; }
    }
}

struct DenseSched {
    const char* A; const char* B; char* O; int ldc; int nM, nN, nwg, G, c;
    __device__ __forceinline__ void decode(int L, int& pm, int& pn) const {
        int wgid = L; { const int q = nwg / 8, r = nwg % 8, xcd = wgid % 8, off = wgid / 8; wgid = (xcd < r ? xcd * (q + 1) : r * (q + 1) + (xcd - r) * q) + off; }
        const int nig = 8 * nN, gid = wgid / nig, fm = gid * 8, gsz = (nM - fm) < 8 ? (nM - fm) : 8;
        pm = fm + ((wgid % nig) % gsz); pn = (wgid % nig) / gsz;
    }
    __device__ __forceinline__ bool next(int i, pg8::Unit& u) const {
        const int L = i * G + c; if (L >= nwg) return false;
        int pm, pn; decode(L, pm, pn);
        u.A = A + (size_t)pm * 256 * 4096; u.B = B + (size_t)pn * 256 * 4096; u.O = O; u.ldc = ldc; u.row0 = pm * 256; u.col0 = pn * 256; u.e = 0; u.cnt = 0; u.tok = nullptr;
        return true;
    }
};
struct P1Sched {
    DenseSched inproj; const char* memn; const char* wk; const char* wv; char* kmem; char* vt; int G, c;
    __device__ __forceinline__ bool next(int i, pg8::Unit& u) const {
        const int L = i * G + c;
        if (L < 512) return inproj.next(i, u);
        const int r = L - 512; if (r >= 32) return false;
        u.e = 0; u.cnt = 0; u.tok = nullptr;
        if (r < 16) { const int pm = r & 1, pn = r >> 1; u.A = memn + (size_t)pm * 256 * 4096; u.B = wk + (size_t)pn * 256 * 4096; u.O = kmem; u.ldc = 2048; u.row0 = pm * 256; u.col0 = pn * 256; }
        else { const int q = r - 16, pm = q >> 1, pn = q & 1; u.A = wv + (size_t)pm * 256 * 4096; u.B = memn + (size_t)pn * 256 * 4096; u.O = vt; u.ldc = 512; u.row0 = pm * 256; u.col0 = pn * 256; }
        return true;
    }
};
struct MoeSched {
    const LAS int* tstart; const int* cnt; const int* tok; const char* A; const char* B; char* O; int nN, colw, G, c; size_t b_es; bool gather;
    __device__ __forceinline__ bool next(int i, pg8::Unit& u) const {
        const int L = i * G + c; const int ntile = tstart[NE];
        if (L >= ntile * nN) return false;
        const int mg = L / nN, pn = L - mg * nN;
        int e = 0;
#pragma unroll 1
        for (int j = 1; j < NE; ++j) e += (tstart[j] <= mg) ? 1 : 0;
        const int mt = mg - tstart[e];
        u.e = e; u.cnt = cnt[64 * e] - mt * 256; u.tok = tok + e * 8192 + mt * 256;
        u.A = gather ? A : A + (size_t)mg * 256 * 4096; u.B = B + (size_t)e * b_es + (size_t)pn * 256 * 4096; u.O = O; u.ldc = 2048; u.row0 = mg * 256; u.col0 = pn * colw;
        return true;
    }
};

constexpr int LD1 = 136;
__device__ __forceinline__ void ssd_chunk_unit(const Args& a, LAS unsigned char* lds, int unit, int tid, int lane, int wave) {
    unsigned char* ws = a.ws;
    const int g = unit & 3, c = (unit >> 2) & 31, b = unit >> 7;
    const int t0 = b * SEQ + c * CHUNK;
    const bf16* P = (const bf16*)(ws + WS_P);
    const float* conv_w = a.in[I_CONV_W]; const float* conv_b = a.in[I_CONV_B];
    LAS bf16* Cm = (LAS bf16*)lds;
    LAS bf16* Bm = (LAS bf16*)(lds + 34816);
    LAS bf16* BmT = (LAS bf16*)(lds + 69632);
    LAS bf16* XT = (LAS bf16*)lds;
    LAS bf16* Gs = (LAS bf16*)(lds + 104448);
    LAS float* dts = (LAS float*)(lds + 139264);
    LAS float* acss = dts + 512;
    LAS float* wls = acss + 512;
    const int fr = lane & 15, fq = lane >> 4;
    {
        const int half = tid >> 8, cc = tid & 255; const bool isC = cc >= 128; const int n = cc & 127;
        const int ch = (isC ? 1536 : 1024) + g * 128 + n;
        const float w0 = conv_w[ch], w1 = conv_w[DCONV + ch], w2 = conv_w[2 * DCONV + ch], w3 = conv_w[3 * DCONV + ch], cb = conv_b[ch];
        const int l0 = half * 64;
        const bf16* src = P + (size_t)t0 * PCOLS + 1024 + ch;
        float r0, r1, r2;
        { const int s = c * CHUNK + l0;
          r0 = (s - 3 >= 0) ? bf2f(src[(ptrdiff_t)(l0 - 3) * PCOLS]) : 0.f; r1 = (s - 2 >= 0) ? bf2f(src[(ptrdiff_t)(l0 - 2) * PCOLS]) : 0.f; r2 = (s - 1 >= 0) ? bf2f(src[(ptrdiff_t)(l0 - 1) * PCOLS]) : 0.f; }
        bf16* cmg = (bf16*)(ws + WS_CMG);
#pragma unroll 1
        for (int o = 0; o < 8; ++o) {
            float raw[8], ov[8];
#pragma unroll
            for (int i = 0; i < 8; ++i) raw[i] = bf2f(src[(size_t)(l0 + o * 8 + i) * PCOLS]);
#pragma unroll
            for (int i = 0; i < 8; ++i) { const float v = w0 * r0 + w1 * r1 + w2 * r2 + w3 * raw[i] + cb; ov[i] = siluf(v); r0 = r1; r1 = r2; r2 = raw[i]; }
            unsigned pk[4];
#pragma unroll
            for (int i = 0; i < 4; ++i) pk[i] = pk2(ov[2 * i], ov[2 * i + 1]);
            const int l = l0 + o * 8;
            if (!isC) {
                *(LAS u32x4*)(BmT + n * LD1 + l) = (u32x4){pk[0], pk[1], pk[2], pk[3]};
#pragma unroll
                for (int i = 0; i < 8; ++i) Bm[(l + i) * LD1 + n] = (bf16)((i & 1) ? (pk[i >> 1] >> 16) : (pk[i >> 1] & 0xffffu));
            } else {
#pragma unroll
                for (int i = 0; i < 8; ++i) { const bf16 hv = (bf16)((i & 1) ? (pk[i >> 1] >> 16) : (pk[i >> 1] & 0xffffu)); Cm[(l + i) * LD1 + n] = hv; cmg[(size_t)(t0 + l + i) * 512 + g * 128 + n] = hv; }
            }
        }
    }
    if (wave < 4) {
        const int h = g * 4 + wave;
        const float* dtraw = (const float*)(ws + WS_DTRAW);
        const float bias = a.in[I_DT_BIAS][h], av = -__expf(a.in[I_A_LOG][h]);
        float d0 = dtraw[(size_t)(t0 + 2 * lane) * 16 + h] + bias, d1 = dtraw[(size_t)(t0 + 2 * lane + 1) * 16 + h] + bias;
        d0 = d0 > 20.f ? d0 : log1pf(__expf(d0)); d1 = d1 > 20.f ? d1 : log1pf(__expf(d1));
        const float v0 = d0 * av, v1 = d1 * av;
        float s = v0 + v1;
#pragma unroll
        for (int o = 1; o < 64; o <<= 1) { const float t = __shfl_up(s, o); if (lane >= o) s += t; }
        const float acs1 = s, acs0 = s - v1;
        const float last = __shfl(s, 63);
        dts[wave * 128 + 2 * lane] = d0; dts[wave * 128 + 2 * lane + 1] = d1;
        acss[wave * 128 + 2 * lane] = acs0; acss[wave * 128 + 2 * lane + 1] = acs1;
        wls[wave * 128 + 2 * lane] = __expf(last - acs0) * d0; wls[wave * 128 + 2 * lane + 1] = __expf(last - acs1) * d1;
        float* acsg = (float*)(ws + WS_ACS);
        acsg[(size_t)(t0 + 2 * lane) * 16 + h] = acs0; acsg[(size_t)(t0 + 2 * lane + 1) * 16 + h] = acs1;
        if (lane == 0) ((float*)(ws + WS_CDEC))[(b * NCH + c) * 16 + h] = __expf(last);
    }
    __syncthreads();
    f32x4 cbv[1][8];
#pragma unroll
    for (int n = 0; n < 8; ++n) cbv[0][n] = (f32x4){0.f, 0.f, 0.f, 0.f};
    wave_mma<1, 8>(cbv, Cm + wave * 16 * LD1, LD1, Bm, LD1, 128, lane);
    __syncthreads();
    {
        const int half = tid >> 8, cc = tid & 255;
        const int ch = g * 256 + cc;
        const float w0 = conv_w[ch], w1 = conv_w[DCONV + ch], w2 = conv_w[2 * DCONV + ch], w3 = conv_w[3 * DCONV + ch], cb = conv_b[ch];
        const int l0 = half * 64;
        const bf16* src = P + (size_t)t0 * PCOLS + 1024 + ch;
        float r0, r1, r2;
        { const int s = c * CHUNK + l0;
          r0 = (s - 3 >= 0) ? bf2f(src[(ptrdiff_t)(l0 - 3) * PCOLS]) : 0.f; r1 = (s - 2 >= 0) ? bf2f(src[(ptrdiff_t)(l0 - 2) * PCOLS]) : 0.f; r2 = (s - 1 >= 0) ? bf2f(src[(ptrdiff_t)(l0 - 1) * PCOLS]) : 0.f; }
        bf16* xs = (bf16*)(ws + WS_XS);
#pragma unroll 1
        for (int o = 0; o < 8; ++o) {
            float raw[8], ov[8];
#pragma unroll
            for (int i = 0; i < 8; ++i) raw[i] = bf2f(src[(size_t)(l0 + o * 8 + i) * PCOLS]);
#pragma unroll
            for (int i = 0; i < 8; ++i) { const float v = w0 * r0 + w1 * r1 + w2 * r2 + w3 * raw[i] + cb; ov[i] = siluf(v); r0 = r1; r1 = r2; r2 = raw[i]; }
            unsigned pk[4];
#pragma unroll
            for (int i = 0; i < 4; ++i) pk[i] = pk2(ov[2 * i], ov[2 * i + 1]);
            const int l = l0 + o * 8;
            *(LAS u32x4*)(XT + cc * LD1 + l) = (u32x4){pk[0], pk[1], pk[2], pk[3]};
#pragma unroll
            for (int i = 0; i < 8; ++i) xs[(size_t)(t0 + l + i) * 1024 + ch] = (bf16)((i & 1) ? (pk[i >> 1] >> 16) : (pk[i >> 1] & 0xffffu));
        }
    }
    __syncthreads();
    const int lrow = wave * 16 + fr;
#pragma unroll 1
    for (int r = 0; r < 4; ++r) {
        const int h = g * 4 + r;
        const float al = acss[r * 128 + lrow];
        LAS bf16* grow = Gs + lrow * LD1;
#pragma unroll
        for (int n = 0; n < 8; ++n) {
            const int s0 = n * 16 + 4 * fq;
            const f32x4 as = *(const LAS f32x4*)(acss + r * 128 + s0), ds = *(const LAS f32x4*)(dts + r * 128 + s0);
            float gv[4];
#pragma unroll
            for (int j = 0; j < 4; ++j) { const float df = fminf(al - as[j], 0.f); gv[j] = (s0 + j <= lrow) ? cbv[0][n][j] * __expf(df) * ds[j] : 0.f; }
            *(LAS u32x2*)(grow + s0) = (u32x2){pk2(gv[0], gv[1]), pk2(gv[2], gv[3])};
        }
        LDS_WAIT(); __builtin_amdgcn_wave_barrier();
        f32x4 yd[1][4];
#pragma unroll
        for (int n = 0; n < 4; ++n) yd[0][n] = (f32x4){0.f, 0.f, 0.f, 0.f};
        wave_mma<1, 4>(yd, Gs + wave * 16 * LD1, LD1, XT + r * 64 * LD1, LD1, 128, lane);
        float* ydg = (float*)(ws + WS_YDIAG) + (size_t)(t0 + lrow) * 1024 + h * 64;
#pragma unroll
        for (int n = 0; n < 4; ++n) *(f32x4*)(ydg + n * 16 + 4 * fq) = yd[0][n];
        f32x4 st[4];
#pragma unroll
        for (int n = 0; n < 4; ++n) st[n] = (f32x4){0.f, 0.f, 0.f, 0.f};
        const LAS bf16* xa = XT + (r * 64 + (wave & 3) * 16 + fr) * LD1;
        const LAS bf16* bt = BmT + ((wave >> 2) * 64 + fr) * LD1;
#pragma unroll
        for (int k0 = 0; k0 < 128; k0 += 32) {
            const u32x4 xr = *(const LAS u32x4*)(xa + k0 + fq * 8);
            const f32x4 wa = *(const LAS f32x4*)(wls + r * 128 + k0 + fq * 8), wb = *(const LAS f32x4*)(wls + r * 128 + k0 + fq * 8 + 4);
            u32x4 xsq; xsq.x = pk2(bflo(xr.x) * wa[0], bfhi(xr.x) * wa[1]); xsq.y = pk2(bflo(xr.y) * wa[2], bfhi(xr.y) * wa[3]);
            xsq.z = pk2(bflo(xr.z) * wb[0], bfhi(xr.z) * wb[1]); xsq.w = pk2(bflo(xr.w) * wb[2], bfhi(xr.w) * wb[3]);
            const bf16x8 af = __builtin_bit_cast(bf16x8, xsq);
#pragma unroll
            for (int n = 0; n < 4; ++n) { const bf16x8 bfv = *(const LAS bf16x8*)(bt + n * 16 * LD1 + k0 + fq * 8); st[n] = __builtin_amdgcn_mfma_f32_16x16x32_bf16(bfv, af, st[n], 0, 0, 0); }
        }
        float* sg = (float*)(ws + WS_STATES) + ((size_t)((b * NCH + c) * 16 + h)) * 8192 + ((wave & 3) * 16 + fr) * 128 + (wave >> 2) * 64;
#pragma unroll
        for (int n = 0; n < 4; ++n) *(f32x4*)(sg + n * 16 + 4 * fq) = st[n];
        __builtin_amdgcn_wave_barrier();
    }
    __syncthreads();
}

constexpr int LD2 = 264;
__device__ __forceinline__ void pool_unit(const Args& a, LAS unsigned char* lds, int unit, int tid, int lane, int wave) {
    unsigned char* ws = a.ws;
    const int g = unit & 3, tt = unit >> 2;
    const int t0 = tt * 128, s0 = t0 & (SEQ - 1);
    const int w = 2 << g;
    const bf16* P = (const bf16*)(ws + WS_P);
    LAS bf16* U = (LAS bf16*)lds;
    LAS bf16* Ap = (LAS bf16*)(lds + 75504);
    LAS bf16* Bt = (LAS bf16*)lds;
    for (int i = tid; i < 143 * 32; i += NTHREADS) { const int r = i >> 5, cv = i & 31; const int s = s0 - 15 + r;
        u32x4 v = (u32x4){0u, 0u, 0u, 0u};
        if (s >= 0) v = *(const u32x4*)(P + (size_t)(t0 - 15 + r) * PCOLS + 3072 + g * 256 + cv * 8);
        *(LAS u32x4*)(U + r * LD2 + cv * 8) = v; }
    __syncthreads();
    {
        const int cc = tid & 255, l0 = (tid >> 8) * 64;
        float sum = 0.f;
        for (int j = 1; j < w; ++j) sum += bf2f(U[(15 + l0 - j) * LD2 + cc]);
        for (int l = l0; l < l0 + 64; ++l) {
            const float ucur = bf2f(U[(15 + l) * LD2 + cc]);
            sum += ucur;
            const int s = s0 + l; const float cntw = (float)((s + 1 < w) ? s + 1 : w);
            Ap[l * LD2 + cc] = (bf16)f2bf(sum / cntw - ucur);
            sum -= bf2f(U[(15 + l - w + 1) * LD2 + cc]);
        }
    }
    __syncthreads();
    const bf16* pw = (const bf16*)(ws + WS_PW) + (size_t)g * 256 * 256;
    const float* pscale = a.in[I_POOL_SCALE];
    bf16* ycat = (bf16*)(ws + WS_YCAT);
    const int fr = lane & 15, fq = lane >> 4;
#pragma unroll 1
    for (int hf = 0; hf < 2; ++hf) {
        tile_g2l(Bt, LD2, pw + (size_t)hf * 128 * 256, 256, 128, 256, tid);
        __syncthreads();
        f32x4 acc[1][8];
#pragma unroll
        for (int n = 0; n < 8; ++n) acc[0][n] = (f32x4){0.f, 0.f, 0.f, 0.f};
        wave_mma<1, 8>(acc, Ap + wave * 16 * LD2, LD2, Bt, LD2, 256, lane);
        bf16* orow = ycat + (size_t)(t0 + wave * 16 + fr) * 2048 + 1024 + g * 256 + hf * 128;
#pragma unroll
        for (int n = 0; n < 8; ++n) { const int d = n * 16 + 4 * fq; const f32x4 sc = *(const f32x4*)(pscale + g * 256 + hf * 128 + d); const f32x4 v = acc[0][n] * sc;
            *(u32x2*)(orow + d) = (u32x2){pk2(v[0], v[1]), pk2(v[2], v[3])}; }
        __syncthreads();
    }
}

__device__ __forceinline__ void ssd_combine_unit(const Args& a, LAS unsigned char* lds, int unit, int tid, int lane, int wave) {
    unsigned char* ws = a.ws;
    const int g = unit & 3, c = (unit >> 2) & 31, b = unit >> 7;
    const int t0 = b * SEQ + c * CHUNK;
    LAS bf16* Cm = (LAS bf16*)lds;
    LAS bf16* Pv = (LAS bf16*)(lds + 34816);
    tile_g2l(Cm, LD1, (const bf16*)(ws + WS_CMG) + (size_t)t0 * 512 + g * 128, 512, 128, 128, tid);
    tile_g2l(Pv, LD1, (const bf16*)(ws + WS_PREV) + ((size_t)((b * NCH + c) * 16 + g * 4)) * 8192, 128, 256, 128, tid);
    __syncthreads();
    const int fr = lane & 15, fq = lane >> 4;
    const int t = t0 + wave * 16 + fr;
    const bf16* P = (const bf16*)(ws + WS_P);
    const float* ydg = (const float*)(ws + WS_YDIAG) + (size_t)t * 1024;
    const bf16* xs = (const bf16*)(ws + WS_XS) + (size_t)t * 1024;
    const float* acsg = (const float*)(ws + WS_ACS) + (size_t)t * 16;
    f32x4 y[4][4]; float ss = 0.f;
#pragma unroll
    for (int r = 0; r < 4; ++r) {
        const int h = g * 4 + r;
        f32x4 yo[1][4];
#pragma unroll
        for (int n = 0; n < 4; ++n) yo[0][n] = (f32x4){0.f, 0.f, 0.f, 0.f};
        wave_mma<1, 4>(yo, Cm + wave * 16 * LD1, LD1, Pv + r * 64 * LD1, LD1, 128, lane);
        const float ea = __expf(acsg[h]), dsk = a.in[I_D_SKIP][h];
#pragma unroll
        for (int n = 0; n < 4; ++n) {
            const int col = h * 64 + n * 16 + 4 * fq;
            const f32x4 yd = *(const f32x4*)(ydg + col);
            const u32x2 xv = *(const u32x2*)(xs + col), zv = *(const u32x2*)(P + (size_t)t * PCOLS + col);
            const float xf[4] = {bflo(xv.x), bfhi(xv.x), bflo(xv.y), bfhi(xv.y)}, zf[4] = {bflo(zv.x), bfhi(zv.x), bflo(zv.y), bfhi(zv.y)};
#pragma unroll
            for (int j = 0; j < 4; ++j) { const float v = (yd[j] + yo[0][n][j] * ea + dsk * xf[j]) * siluf(zf[j]); y[r][n][j] = v; ss += v * v; }
        }
    }
    ss += __shfl_xor(ss, 16); ss += __shfl_xor(ss, 32);
    const float rstd = rsqrtf(ss * (1.f / 256.f) + EPS);
    const float* nw = a.in[I_SSD_NORM] + g * 256;
    bf16* orow = (bf16*)(ws + WS_YCAT) + (size_t)t * 2048 + g * 256;
#pragma unroll
    for (int r = 0; r < 4; ++r)
#pragma unroll
        for (int n = 0; n < 4; ++n) { const int col = r * 64 + n * 16 + 4 * fq; const f32x4 w4 = *(const f32x4*)(nw + col); const f32x4 v = y[r][n] * rstd * w4;
            *(u32x2*)(orow + col) = (u32x2){pk2(v[0], v[1]), pk2(v[2], v[3])}; }
    __syncthreads();
}

__device__ __forceinline__ void attn_unit(const Args& a, LAS unsigned char* lds, int unit, int tid, int lane, int wave) {
    unsigned char* ws = a.ws;
    const int h = unit & 3, qt = (unit >> 2) & 31, b = unit >> 7;
    const int t0 = b * SEQ + qt * 128;
    const bf16* q = (const bf16*)(ws + WS_Q); const bf16* km = (const bf16*)(ws + WS_KMEM); const bf16* vt = (const bf16*)(ws + WS_VT);
    LAS bf16* Qc = (LAS bf16*)lds;
    LAS bf16* Kc = (LAS bf16*)(lds + 34816);
    LAS bf16* Ps = (LAS bf16*)lds;
    LAS bf16* Vc = (LAS bf16*)(lds + 67584);
    const int fr = lane & 15, fq = lane >> 4;
    f32x4 s[1][16];
#pragma unroll
    for (int n = 0; n < 16; ++n) s[0][n] = (f32x4){0.f, 0.f, 0.f, 0.f};
#pragma unroll 1
    for (int dc = 0; dc < 4; ++dc) {
        tile_g2l(Qc, LD1, q + (size_t)t0 * 2048 + h * 512 + dc * 128, 2048, 128, 128, tid);
        tile_g2l(Kc, LD1, km + (size_t)(b * NMEM) * 2048 + h * 512 + dc * 128, 2048, 256, 128, tid);
        __syncthreads();
        wave_mma<1, 16>(s, Qc + wave * 16 * LD1, LD1, Kc, LD1, 128, lane);
        __syncthreads();
    }
    float mx = -3.0e38f;
#pragma unroll
    for (int n = 0; n < 16; ++n)
#pragma unroll
        for (int j = 0; j < 4; ++j) mx = fmaxf(mx, s[0][n][j]);
    mx = fmaxf(mx, __shfl_xor(mx, 16)); mx = fmaxf(mx, __shfl_xor(mx, 32));
    float sum = 0.f;
#pragma unroll
    for (int n = 0; n < 16; ++n)
#pragma unroll
        for (int j = 0; j < 4; ++j) { const float e = __expf(s[0][n][j] - mx); s[0][n][j] = e; sum += e; }
    sum += __shfl_xor(sum, 16); sum += __shfl_xor(sum, 32);
    const float inv = 1.0f / sum;
    LAS bf16* prow = Ps + (wave * 16 + fr) * LD2;
#pragma unroll
    for (int n = 0; n < 16; ++n) { const f32x4 p = s[0][n] * inv; *(LAS u32x2*)(prow + n * 16 + 4 * fq) = (u32x2){pk2(p[0], p[1]), pk2(p[2], p[3])}; }
    bf16* orow = (bf16*)(ws + WS_O) + (size_t)(t0 + wave * 16 + fr) * 2048 + h * 512;
#pragma unroll 1
    for (int dc = 0; dc < 4; ++dc) {
        tile_g2l(Vc, LD2, vt + (size_t)(h * 512 + dc * 128) * 512 + b * NMEM, 512, 128, 256, tid);
        __syncthreads();
        f32x4 o[1][8];
#pragma unroll
        for (int n = 0; n < 8; ++n) o[0][n] = (f32x4){0.f, 0.f, 0.f, 0.f};
        wave_mma<1, 8>(o, Ps + wave * 16 * LD2, LD2, Vc, LD2, 256, lane);
#pragma unroll
        for (int n = 0; n < 8; ++n) *(u32x2*)(orow + dc * 128 + n * 16 + 4 * fq) = (u32x2){pk2(o[0][n][0], o[0][n][1]), pk2(o[0][n][2], o[0][n][3])};
        __syncthreads();
    }
}

__device__ __forceinline__ void router_phase(const Args& a, LAS unsigned char* lds, int tid, int lane, int wave, int vcu, int G) {
    unsigned char* ws = a.ws;
    LAS bf16* wr = (LAS bf16*)lds;
    LAS int* pick_e = (LAS int*)(lds + 131072);
    LAS float* pick_g = (LAS float*)(lds + 131072 + 512);
    LAS int* pick_lp = (LAS int*)(lds + 131072 + 1024);
    LAS int* lcnt = (LAS int*)(lds + 131072 + 1536);
    LAS int* lbase = lcnt + 32;
    { const u32x4* src = (const u32x4*)(ws + WS_WR); for (int i = tid; i < 32 * 2048 / 8; i += NTHREADS) ((LAS u32x4*)wr)[i] = src[i]; }
    const float* h2 = (const float*)(ws + WS_H2); const float* nw = a.in[I_NORM_FFN]; const float* brt = a.in[I_B_ROUTER];
    bf16* hn = (bf16*)(ws + WS_HN);
    unsigned* ctl = (unsigned*)(ws + WS_CTL);
    int* tok_of = (int*)(ws + WS_TOK); int* rec_e = (int*)(ws + WS_REC); int* rec_p = rec_e + T * 4; float* rec_g = (float*)(rec_p + T * 4);
    for (int base = vcu * 32; base < T; base += G * 32) {
        if (tid < 32) lcnt[tid] = 0;
        __syncthreads();
#pragma unroll 1
        for (int i = 0; i < 4; ++i) {
            const int lr = wave * 4 + i, m = base + lr;
            const f32x4* xr = (const f32x4*)(h2 + (size_t)m * D) + lane;
            f32x4 v[8]; float ss = 0.f;
#pragma unroll
            for (int j = 0; j < 8; ++j) { v[j] = xr[64 * j]; ss += (v[j].x * v[j].x + v[j].y * v[j].y) + (v[j].z * v[j].z + v[j].w * v[j].w); }
            const float rstd = rsqrtf(wave_sum(ss) * (1.f / D) + EPS);
            u32x2* o8 = (u32x2*)(hn + (size_t)m * D) + lane;
#pragma unroll
            for (int j = 0; j < 8; ++j) { const f32x4 w4 = ((const f32x4*)nw)[lane + 64 * j]; v[j] = v[j] * rstd * w4; u32x2 w; w.x = pk2(v[j].x, v[j].y); w.y = pk2(v[j].z, v[j].w); o8[64 * j] = w; }
            float lg = -3.0e38f;
#pragma unroll 1
            for (int e = 0; e < NE; ++e) {
                const LAS u32x2* wrow = (const LAS u32x2*)(wr + e * 2048) + lane; float p = 0.f;
#pragma unroll
                for (int j = 0; j < 8; ++j) { const u32x2 w2 = wrow[64 * j]; p += (v[j].x * bflo(w2.x) + v[j].y * bfhi(w2.x)) + (v[j].z * bflo(w2.y) + v[j].w * bfhi(w2.y)); }
                p = wave_sum(p); if (lane == e) lg = p + brt[e];
            }
            float tv[4]; int ti[4];
#pragma unroll
            for (int k = 0; k < 4; ++k) {
                float bv = lg; int bi = lane;
#pragma unroll
                for (int o = 1; o < 64; o <<= 1) { const float ov = __shfl_xor(bv, o); const int oi = __shfl_xor(bi, o); if (ov > bv || (ov == bv && oi < bi)) { bv = ov; bi = oi; } }
                tv[k] = bv; ti[k] = bi; if (lane == bi) lg = -3.0e38f;
            }
            const float e1 = __expf(tv[1] - tv[0]), e2 = __expf(tv[2] - tv[0]), e3 = __expf(tv[3] - tv[0]); const float inv = 1.0f / (1.0f + e1 + e2 + e3);
            if (lane < 4) { const int ee = lane == 0 ? ti[0] : lane == 1 ? ti[1] : lane == 2 ? ti[2] : ti[3]; const float gg = (lane == 0 ? 1.0f : lane == 1 ? e1 : lane == 2 ? e2 : e3) * inv;
                pick_e[lr * 4 + lane] = ee; pick_g[lr * 4 + lane] = gg; }
        }
        __syncthreads();
        if (tid < 128) pick_lp[tid] = atomicAdd((int*)&lcnt[pick_e[tid]], 1);
        __syncthreads();
        if (tid < 32) { const int n = lcnt[tid]; lbase[tid] = n ? (int)__hip_atomic_fetch_add(ctl + CW_CNT + 64 * tid, (unsigned)n, __ATOMIC_RELAXED, __HIP_MEMORY_SCOPE_AGENT) : 0; }
        __syncthreads();
        if (tid < 128) { const int e = pick_e[tid], pos = lbase[e] + pick_lp[tid], m = base + (tid >> 2);
            tok_of[e * 8192 + pos] = m; rec_e[m * 4 + (tid & 3)] = e; rec_p[m * 4 + (tid & 3)] = pos; rec_g[m * 4 + (tid & 3)] = pick_g[tid]; }
        __syncthreads();
    }
}

__device__ __forceinline__ void moe_tile_starts(const unsigned* ctl, LAS int* ts, int tid) {
    if (tid < 64) {
        const int c = (tid < NE) ? (int)__hip_atomic_load(ctl + CW_CNT + 64 * tid, __ATOMIC_RELAXED, __HIP_MEMORY_SCOPE_AGENT) : 0;
        const int nt = (c + 255) >> 8; int s = nt;
#pragma unroll
        for (int o = 1; o < 64; o <<= 1) { const int t = __shfl_up(s, o); if (tid >= o) s += t; }
        if (tid < NE) ts[tid] = s - nt;
        if (tid == NE - 1) ts[NE] = s;
    }
    __syncthreads();
}

__device__ __forceinline__ void final_phase(const Args& a, LAS unsigned char* lds, int tid, int lane, int wave, int vcu, int G) {
    unsigned char* ws = a.ws;
    LAS int* ts = (LAS int*)lds;
    moe_tile_starts((const unsigned*)(ws + WS_CTL), ts, tid);
#ifndef FINAL_MODE
#define FINAL_MODE 0
#endif
    const float* h2 = (FINAL_MODE == 1) ? (const float*)(ws + WS_H1) : (FINAL_MODE == 3) ? a.in[I_X] : (const float*)(ws + WS_H2); const float* nw = a.in[I_NORM_FINAL]; const bf16* y = (const bf16*)(ws + WS_Y);
    const int* rec_e = (const int*)(ws + WS_REC); const int* rec_p = rec_e + T * 4; const float* rec_g = (const float*)(rec_p + T * 4);
    const float* bd = a.in[I_B_DOWN];
    const int gw = vcu * NWAVES + wave, NGW = G * NWAVES;
    f32x4 wv[8];
#pragma unroll
    for (int j = 0; j < 8; ++j) wv[j] = ((const f32x4*)nw)[lane + 64 * j];
    for (int m = gw; m < T; m += NGW) {
        const f32x4* xr = (const f32x4*)(h2 + (size_t)m * D) + lane;
        f32x4 v[8];
#pragma unroll
        for (int j = 0; j < 8; ++j) v[j] = xr[64 * j];
#pragma unroll 1
        for (int k = 0; k < (FINAL_MODE ? 0 : 4); ++k) {
            const int e = rec_e[m * 4 + k], pos = rec_p[m * 4 + k]; const float gt = rec_g[m * 4 + k];
            const int slot = ts[e] * 256 + pos;
            const u32x2* yr = (const u32x2*)(y + (size_t)slot * 2048) + lane;
#pragma unroll
            for (int j = 0; j < 8; ++j) { const u32x2 w2 = yr[64 * j]; v[j].x += gt * bflo(w2.x); v[j].y += gt * bfhi(w2.x); v[j].z += gt * bflo(w2.y); v[j].w += gt * bfhi(w2.y); }
        }
        float ss = 0.f;
#pragma unroll
        for (int j = 0; j < 8; ++j) ss += (v[j].x * v[j].x + v[j].y * v[j].y) + (v[j].z * v[j].z + v[j].w * v[j].w);
        const float rstd = rsqrtf(wave_sum(ss) * (1.f / D) + EPS);
        f32x4* o = (f32x4*)(a.out + (size_t)m * D) + lane;
#pragma unroll
        for (int j = 0; j < 8; ++j) { f32x4 r = v[j] * rstd * wv[j];
#ifdef SANITIZE
            for (int q = 0; q < 4; ++q) if (!(fabsf(r[q]) < 1e30f)) r[q] = 0.f;
#endif
            o[64 * j] = r; }
    }
    (void)bd;
}

__global__ void __launch_bounds__(NTHREADS, 2) hybrid_fwd(Args args) {
    extern __shared__ __attribute__((aligned(16))) unsigned char lds_raw[];
    LAS unsigned char* lds = (LAS unsigned char*)lds_raw;
    volatile LAS unsigned* MISC = (volatile LAS unsigned*)(lds + MISC_OFF);
    const int tid = threadIdx.x, lane = tid & 63, wave = __builtin_amdgcn_readfirstlane(tid >> 6);
    const int G = gridDim.x; const int bx = blockIdx.x; const int vcu = (G % 8 == 0) ? (bx % 8) * (G / 8) + bx / 8 : bx;
    unsigned char* ws = args.ws;
    unsigned* ctl = (unsigned*)(ws + WS_CTL);
    for (int u = tid; u < (LDS_BYTES - MISC_OFF) / 4; u += NTHREADS) ((LAS unsigned*)(lds + MISC_OFF))[u] = 0u;
    __syncthreads();
    XcdBarrier bar; bar.bar = ctl + CW_BAR; bar.x = 0; bar.st = nullptr;
    if (MK_LAUNCHES == 1) bar = xcd_barrier_post(ctl + CW_BAR, MISC + 8);
    const int lo = args.ph_lo, hi = args.ph_hi;
#ifndef PHASE_MASK
#define PHASE_MASK 0x3fff
#endif
#define IN(k) ((((PHASE_MASK) >> (k)) & 1) && lo <= (k) && (k) < hi)
#define SEAM(k) do { if (IN(k) && IN((k) + 1)) xcd_barrier(bar); } while (0)

    if (IN(0)) { p0_prologue(args, lds, tid, lane, wave, vcu, G); SEAM(0); }

    if (IN(1)) {
        P1Sched S; S.G = G; S.c = bx;
        S.inproj = DenseSched{(const char*)(ws + WS_HN), (const char*)(ws + WS_WIN), (char*)(ws + WS_P), PCOLS, 32, 16, 512, G, bx};
        S.memn = (const char*)(ws + WS_MEMN); S.wk = (const char*)(ws + WS_WK); S.wv = (const char*)(ws + WS_WV); S.kmem = (char*)(ws + WS_KMEM); S.vt = (char*)(ws + WS_VT);
        pg8::EpiBf16P<0> E;
        pg8::gemm_phase<pg8::EpiBf16P<0>, P1Sched, false>(lds, S, E);
        SEAM(1);
    }
    if (IN(2)) {
        for (int u = vcu; u < 256; u += G) ssd_chunk_unit(args, lds, u, tid, lane, wave);
        for (int u = vcu; u < 256; u += G) pool_unit(args, lds, u, tid, lane, wave);
        SEAM(2);
    }
    if (IN(3)) {
        const float* st = (const float*)(ws + WS_STATES); const float* cdec = (const float*)(ws + WS_CDEC); bf16* prev = (bf16*)(ws + WS_PREV);
        for (int idx = bx * NTHREADS + tid; idx < NB * 16 * 4096; idx += G * NTHREADS) {
            const int b = idx >> 16, rem = idx & 65535, h = rem >> 12, e2 = rem & 4095;
            float h0 = 0.f, h1 = 0.f;
#pragma unroll 4
            for (int c = 0; c < NCH; ++c) {
                const size_t o = ((size_t)((b * NCH + c) * 16 + h)) * 8192 + e2 * 2;
                const f32x2 s = *(const f32x2*)(st + o); const float dc = cdec[(b * NCH + c) * 16 + h];
                *(unsigned*)(prev + o) = pk2(h0, h1);
                h0 = h0 * dc + s.x; h1 = h1 * dc + s.y;
            }
        }
        SEAM(3);
    }
    if (IN(4)) { for (int u = vcu; u < 256; u += G) ssd_combine_unit(args, lds, u, tid, lane, wave); SEAM(4); }
    if (IN(5)) {
        DenseSched S{(const char*)(ws + WS_YCAT), (const char*)(ws + WS_WOUT), nullptr, 2048, 32, 8, 256, G, bx};
        pg8::EpiF32Res E{args.in[I_X], (float*)(ws + WS_H1), 2048};
        pg8::gemm_phase<pg8::EpiF32Res, DenseSched, false>(lds, S, E);
        SEAM(5);
    }
    if (IN(6)) { rms_rows_bf16((const float*)(ws + WS_H1), args.in[I_NORM_XATTN], (bf16*)(ws + WS_HN), T, vcu * NWAVES + wave, G * NWAVES, lane); SEAM(6); }
    if (IN(7)) {
        DenseSched S{(const char*)(ws + WS_HN), (const char*)(ws + WS_WQ), (char*)(ws + WS_Q), 2048, 32, 8, 256, G, bx};
        pg8::EpiBf16P<1> E;
        pg8::gemm_phase<pg8::EpiBf16P<1>, DenseSched, false>(lds, S, E);
        SEAM(7);
    }
    if (IN(8)) { for (int u = vcu; u < 256; u += G) attn_unit(args, lds, u, tid, lane, wave); SEAM(8); }
    if (IN(9)) {
        DenseSched S{(const char*)(ws + WS_O), (const char*)(ws + WS_WO), nullptr, 2048, 32, 8, 256, G, bx};
        pg8::EpiF32Res E{(const float*)(ws + WS_H1), (float*)(ws + WS_H2), 2048};
        pg8::gemm_phase<pg8::EpiF32Res, DenseSched, false>(lds, S, E);
        SEAM(9);
    }
    if (IN(10)) { router_phase(args, lds, tid, lane, wave, vcu, G); SEAM(10); }
    if (IN(11)) {
        LAS int* ts = (LAS int*)(lds + 131072);
        moe_tile_starts(ctl, ts, tid);
        MoeSched S{ts, (const int*)(ctl + CW_CNT), (const int*)(ws + WS_TOK), (const char*)(ws + WS_HN), (const char*)(ws + WS_WGU), (char*)(ws + WS_ACT), 16, 128, G, bx, (size_t)4096 * 4096, true};
        pg8::EpiSwiglu E{args.in[I_B_GATE], args.in[I_B_UP]};
        pg8::gemm_phase<pg8::EpiSwiglu, MoeSched, true>(lds, S, E);
        SEAM(11);
    }
    if (IN(12)) {
        LAS int* ts = (LAS int*)(lds + 131072);
        moe_tile_starts(ctl, ts, tid);
        MoeSched S{ts, (const int*)(ctl + CW_CNT), (const int*)(ws + WS_TOK), (const char*)(ws + WS_ACT), (const char*)(ws + WS_WD), (char*)(ws + WS_Y), 8, 256, G, bx, (size_t)2048 * 4096, false};
        pg8::EpiBf16B E{args.in[I_B_DOWN], 2048};
        pg8::gemm_phase<pg8::EpiBf16B, MoeSched, false>(lds, S, E);
        SEAM(12);
    }
#ifdef DIAG
    if (lo <= 13 && 13 < hi) {
        unsigned flags = 0;
        const size_t gt = (size_t)bx * NTHREADS + tid, gn = (size_t)G * NTHREADS;
    }
    if (lo <= 14 && 14 < hi) {
        for (size_t i = (size_t)bx * NTHREADS + tid; i < (size_t)T * D; i += (size_t)G * NTHREADS) args.out[i] = 0.f;
        if (bx == 0 && tid == 0) args.out[0] = 1000.0f * (float)ctl[10];
    }
#else
    if (IN(13)) { final_phase(args, lds, tid, lane, wave, vcu, G); }
#endif
#undef IN
#undef SEAM
}

extern "C" void kernel_launch(void* const* d_in, const int* in_sizes, int n_in, void* d_out, int out_size, void* d_ws, size_t ws_size, hipStream_t stream) {
    static int grid = 0;
    if (grid == 0) {
        if (n_in != 28 || out_size != T * D || ws_size < WS_END) { fprintf(stderr, "kernel_launch: unexpected shapes (n_in %d, out %d, ws %zu < %zu)\n", n_in, out_size, ws_size, (size_t)WS_END); grid = -1; return; }
        int dev = 0, cus = 0, per_cu = 0;
        if (hipGetDevice(&dev) != hipSuccess || hipDeviceGetAttribute(&cus, hipDeviceAttributeMultiprocessorCount, dev) != hipSuccess) { grid = -1; return; }
        if (hipFuncSetAttribute((const void*)hybrid_fwd, hipFuncAttributeMaxDynamicSharedMemorySize, LDS_BYTES) != hipSuccess) { fprintf(stderr, "kernel_launch: hipFuncSetAttribute failed\n"); grid = -1; return; }
        if (hipOccupancyMaxActiveBlocksPerMultiprocessor(&per_cu, (const void*)hybrid_fwd, NTHREADS, LDS_BYTES) != hipSuccess || per_cu < 1)
            fprintf(stderr, "kernel_launch: occupancy query reports %d workgroups per CU\n", per_cu);
        (void)hipGetLastError();
        grid = cus;
    }
    if (grid < 0) return;
    if (hipMemsetAsync((char*)d_ws + WS_CTL, 0, CTL_ZERO_BYTES, stream) != hipSuccess) return;
    Args a{};
    for (int i = 0; i < 28; ++i) a.in[i] = (const float*)d_in[i];
    a.out = (float*)d_out; a.ws = (unsigned char*)d_ws; a.pad = 0;
    for (int li = 0; li < MK_LAUNCHES; ++li) {
        a.ph_lo = (MK_LAUNCHES == 1) ? 0 : li; a.ph_hi = (MK_LAUNCHES == 1) ? NPHASE + 1 : li + 1; a.li = li;
        hipLaunchKernelGGL(hybrid_fwd, dim3(grid), dim3(NTHREADS), LDS_BYTES, stream, a);
        const hipError_t le = hipPeekAtLastError();
        if (le != hipSuccess) { fprintf(stderr, "kernel_launch: launch %d failed: %s\n", li, hipGetErrorName(le)); break; }
    }
}
```

```cpp
#include <hip/hip_runtime.h>
#include <cstdio>
#include <cstdint>

#ifndef MK_LAUNCHES
#define MK_LAUNCHES 1
#endif

#define GAS __attribute__((address_space(1)))
#define LAS __attribute__((address_space(3)))
typedef unsigned short bf16;
typedef short bf16x8 __attribute__((ext_vector_type(8)));
typedef float f32x4 __attribute__((ext_vector_type(4)));
typedef float f32x2 __attribute__((ext_vector_type(2)));
typedef unsigned u32x4 __attribute__((ext_vector_type(4)));
typedef unsigned u32x2 __attribute__((ext_vector_type(2)));
typedef int i32x8 __attribute__((ext_vector_type(8)));
typedef int i32x4 __attribute__((ext_vector_type(4)));

constexpr int NB = 2, SEQ = 4096, T = NB * SEQ, D = 2048;
constexpr int DSSD = 1024, HEADS = 16, HD = 64, GROUPS = 4, NST = 128, CHUNK = 128, NCH = SEQ / CHUNK;
constexpr int DIN = 4112, PCOLS = 4096;
constexpr int DCONV = 2048;
constexpr int NMEM = 256, XH = 4, XHD = 512;
constexpr int NE = 32, TOPK = 4;
constexpr int SLOT_CAP = 41216;
constexpr float EPS = 1e-5f;
constexpr int NTHREADS = 512, NWAVES = 8;
constexpr int NPHASE = 14;

constexpr size_t MiB = 1u << 20;
constexpr size_t WS_CTL = 0, CTL_ZERO_BYTES = 1 * MiB;
constexpr size_t WS_WIN = 1 * MiB;
constexpr size_t WS_WOUT = WS_WIN + 16 * MiB;
constexpr size_t WS_WQ = WS_WOUT + 8 * MiB;
constexpr size_t WS_WK = WS_WQ + 8 * MiB;
constexpr size_t WS_WV = WS_WK + 8 * MiB;
constexpr size_t WS_WO = WS_WV + 8 * MiB;
constexpr size_t WS_PW = WS_WO + 8 * MiB;
constexpr size_t WS_WR = WS_PW + 1 * MiB;
constexpr size_t WS_WGU = WS_WR + 1 * MiB;
constexpr size_t WS_WD = WS_WGU + 512 * MiB;
constexpr size_t WS_HN = WS_WD + 256 * MiB;
constexpr size_t WS_MEMN = WS_HN + 32 * MiB;
constexpr size_t WS_P = WS_MEMN + 2 * MiB;
constexpr size_t WS_DTRAW = WS_P + 64 * MiB;
constexpr size_t WS_ACS = WS_DTRAW + 1 * MiB;
constexpr size_t WS_CDEC = WS_ACS + 1 * MiB;
constexpr size_t WS_KMEM = WS_CDEC + 1 * MiB;
constexpr size_t WS_VT = WS_KMEM + 2 * MiB;
constexpr size_t WS_XS = WS_VT + 2 * MiB;
constexpr size_t WS_CMG = WS_XS + 16 * MiB;
constexpr size_t WS_YDIAG = WS_CMG + 8 * MiB;
constexpr size_t WS_STATES = WS_YDIAG + 32 * MiB;
constexpr size_t WS_PREV = WS_STATES + 32 * MiB;
constexpr size_t WS_YCAT = WS_PREV + 16 * MiB;
constexpr size_t WS_H1 = WS_YCAT + 32 * MiB;
constexpr size_t WS_H2 = WS_H1 + 64 * MiB;
constexpr size_t WS_Q = WS_H2 + 64 * MiB;
constexpr size_t WS_O = WS_Q + 32 * MiB;
constexpr size_t WS_TOK = WS_O + 32 * MiB;
constexpr size_t WS_REC = WS_TOK + 1 * MiB;
constexpr size_t WS_ACT = WS_REC + 1 * MiB;
constexpr size_t WS_Y = WS_ACT + 162 * MiB;
constexpr size_t WS_END = WS_Y + 162 * MiB;
static_assert((size_t)SLOT_CAP * 2048 * 2 <= 162 * MiB, "act");

constexpr int CW_BAR = 4096;
constexpr int CW_CNT = 16384;

constexpr int LDS_BYTES = 147456;
constexpr int MISC_OFF = 146944;

#define LDS_WAIT() asm volatile("s_waitcnt lgkmcnt(0)" ::: "memory")
#define VM_WAIT() asm volatile("s_waitcnt vmcnt(0)" ::: "memory")

__device__ __forceinline__ unsigned f2bf(float f) { unsigned u = __builtin_bit_cast(unsigned, f); return (u + 0x7fffu + ((u >> 16) & 1u)) >> 16; }
typedef __bf16 bf16x2_t __attribute__((ext_vector_type(2)));
__device__ __forceinline__ unsigned pk2(float lo, float hi) { const f32x2 v = {lo, hi}; const bf16x2_t b = __builtin_convertvector(v, bf16x2_t); return __builtin_bit_cast(unsigned, b); }
__device__ __forceinline__ unsigned pk4_fp8(float a, float b, float c, float d) { unsigned w = 0u; w = (unsigned)__builtin_amdgcn_cvt_pk_fp8_f32(a, b, (int)w, false); w = (unsigned)__builtin_amdgcn_cvt_pk_fp8_f32(c, d, (int)w, true); return w; }
__device__ __forceinline__ float bf2f(unsigned b) { return __builtin_bit_cast(float, b << 16); }
__device__ __forceinline__ float bflo(unsigned w) { return __builtin_bit_cast(float, w << 16); }
__device__ __forceinline__ float bfhi(unsigned w) { return __builtin_bit_cast(float, w & 0xffff0000u); }
__device__ __forceinline__ float wave_sum(float v) {
#pragma unroll
    for (int o = 1; o < 64; o <<= 1) v += __shfl_xor(v, o);
    return v;
}
__device__ __forceinline__ float siluf(float x) { return x / (1.0f + __expf(-x)); }

namespace pg8 {
constexpr int BM = 256, BK = 64, HALF = 128, HTB = HALF * BK * 2, STAGE_BYTES = 8 * HTB, KD = 2048;
__host__ __device__ __forceinline__ int lds_byte(int r, int c) { const int st = (r >> 4) * 2 + (c >> 5), rr = r & 15, cc = c & 31, ob = rr * 64 + cc * 2; return st * 1024 + (ob ^ (((ob >> 9) & 1) << 5)); }
__host__ __device__ __forceinline__ void stage_rc(int b, int& R, int& C) { const int st = b / 1024, sb = b % 1024, swz = sb ^ (((sb >> 9) & 1) << 5); R = (st >> 1) * 16 + swz / 64; C = (st & 1) * 32 + (swz % 64) / 2; }
__host__ __device__ __forceinline__ int perm32(int rho) { const int n = rho >> 4, i = rho & 15; return 8 * (i >> 2) + 4 * n + (i & 3); }

struct Unit { const char* A; const char* B; char* O; const int* tok; int ldc, row0, col0, e, cnt, ui; };

template <int SC> struct EpiBf16P {
    static constexpr bool PERM = true;
    __device__ __forceinline__ void operator()(const f32x4 (&acc)[2][2][4][2], const Unit& u, int wr, int wc, int fr, int fq) const {
        const float scale = SC ? 0.04419417382415922f : 1.0f;
        const int rowt = wr * 64 + fr, colt = wc * 32 + 8 * fq;
        bf16* base = (bf16*)u.O;
#pragma unroll
        for (int ai = 0; ai < 2; ++ai)
#pragma unroll
            for (int m = 0; m < 4; ++m) { bf16* rowp = base + (size_t)(u.row0 + rowt + ai * HALF + m * 16) * u.ldc + u.col0 + colt;
#pragma unroll
                for (int bj = 0; bj < 2; ++bj) { const f32x4 v0 = acc[ai][bj][m][0] * scale, v1 = acc[ai][bj][m][1] * scale;
                    u32x4 w; w.x = pk2(v0[0], v0[1]); w.y = pk2(v0[2], v0[3]); w.z = pk2(v1[0], v1[1]); w.w = pk2(v1[2], v1[3]);
                    *(u32x4*)(rowp + bj * HALF) = w; } }
    }
};
struct EpiBf16B {
    static constexpr bool PERM = true;
    const float* bias; int bias_stride;
    __device__ __forceinline__ void operator()(const f32x4 (&acc)[2][2][4][2], const Unit& u, int wr, int wc, int fr, int fq) const {
        const int rowt = wr * 64 + fr, colt = wc * 32 + 8 * fq;
        bf16* base = (bf16*)u.O;
        f32x4 bv[2][2];
#pragma unroll
        for (int bj = 0; bj < 2; ++bj)
#pragma unroll
            for (int n = 0; n < 2; ++n) bv[bj][n] = *(const f32x4*)(bias + (size_t)u.e * bias_stride + u.col0 + colt + bj * HALF + 4 * n);
#pragma unroll
        for (int ai = 0; ai < 2; ++ai)
#pragma unroll
            for (int m = 0; m < 4; ++m) { bf16* rowp = base + (size_t)(u.row0 + rowt + ai * HALF + m * 16) * u.ldc + u.col0 + colt;
#pragma unroll
                for (int bj = 0; bj < 2; ++bj) { const f32x4 v0 = acc[ai][bj][m][0] + bv[bj][0], v1 = acc[ai][bj][m][1] + bv[bj][1];
                    u32x4 w; w.x = pk2(v0[0], v0[1]); w.y = pk2(v0[2], v0[3]); w.z = pk2(v1[0], v1[1]); w.w = pk2(v1[2], v1[3]);
                    *(u32x4*)(rowp + bj * HALF) = w; } }
    }
};
struct EpiF32Res {
    static constexpr bool PERM = false;
    const float* base; float* out; int ldc;
    __device__ __forceinline__ void operator()(const f32x4 (&acc)[2][2][4][2], const Unit& u, int wr, int wc, int fr, int fq) const {
        const int row0 = u.row0 + wr * 64 + fr, col0 = u.col0 + wc * 32 + 4 * fq;
#pragma unroll
        for (int ai = 0; ai < 2; ++ai)
#pragma unroll
            for (int m = 0; m < 4; ++m) { const size_t off = (size_t)(row0 + ai * HALF + m * 16) * ldc + col0;
#pragma unroll
                for (int bj = 0; bj < 2; ++bj)
#pragma unroll
                    for (int n = 0; n < 2; ++n) { const f32x4 bs = *(const f32x4*)(base + off + bj * HALF + n * 16); *(f32x4*)(out + off + bj * HALF + n * 16) = bs + acc[ai][bj][m][n]; } }
    }
};
template <bool BASE_F32> struct EpiResBf16 {
    static constexpr bool PERM = true;
    const void* base; bf16* out; int ldc;
    __device__ __forceinline__ void operator()(const f32x4 (&acc)[2][2][4][2], const Unit& u, int wr, int wc, int fr, int fq) const {
        const int row0 = u.row0 + wr * 64 + fr, col0 = u.col0 + wc * 32 + 8 * fq;
#pragma unroll
        for (int ai = 0; ai < 2; ++ai)
#pragma unroll
            for (int m = 0; m < 4; ++m) { const size_t off = (size_t)(row0 + ai * HALF + m * 16) * ldc + col0;
#pragma unroll
                for (int bj = 0; bj < 2; ++bj) { f32x4 b0, b1;
                    if constexpr (BASE_F32) { b0 = *(const f32x4*)((const float*)base + off + bj * HALF); b1 = *(const f32x4*)((const float*)base + off + bj * HALF + 4); }
                    else { const u32x4 t = *(const u32x4*)((const bf16*)base + off + bj * HALF); b0 = (f32x4){bflo(t.x), bfhi(t.x), bflo(t.y), bfhi(t.y)}; b1 = (f32x4){bflo(t.z), bfhi(t.z), bflo(t.w), bfhi(t.w)}; }
                    const f32x4 v0 = b0 + acc[ai][bj][m][0], v1 = b1 + acc[ai][bj][m][1];
                    u32x4 w; w.x = pk2(v0[0], v0[1]); w.y = pk2(v0[2], v0[3]); w.z = pk2(v1[0], v1[1]); w.w = pk2(v1[2], v1[3]);
                    *(u32x4*)(out + off + bj * HALF) = w; } }
    }
};
struct EpiSwiglu {
    static constexpr bool PERM = true;
    const float* bg; const float* bu;
    __device__ __forceinline__ void operator()(const f32x4 (&acc)[2][2][4][2], const Unit& u, int wr, int wc, int fr, int fq) const {
        const int rowt = wr * 64 + fr, colt = u.col0 + wc * 32 + 8 * fq;
        f32x4 g_[2], u_[2];
#pragma unroll
        for (int n = 0; n < 2; ++n) { g_[n] = *(const f32x4*)(bg + (size_t)u.e * 2048 + colt + 4 * n); u_[n] = *(const f32x4*)(bu + (size_t)u.e * 2048 + colt + 4 * n); }
#pragma unroll
        for (int ai = 0; ai < 2; ++ai)
#pragma unroll
            for (int m = 0; m < 4; ++m) { unsigned char* rowp = (unsigned char*)u.O + (size_t)(u.row0 + rowt + ai * HALF + m * 16) * 2048 + colt;
                float a[8];
#pragma unroll
                for (int n = 0; n < 2; ++n)
#pragma unroll
                    for (int j = 0; j < 4; ++j) { float g = acc[ai][0][m][n][j] + g_[n][j], up = acc[ai][1][m][n][j] + u_[n][j];
                        g = fminf(g, 7.0f); up = fminf(fmaxf(up, -7.0f), 7.0f);
                        a[n * 4 + j] = g * __builtin_amdgcn_rcpf(1.0f + __expf(-1.702f * g)) * (up + 1.0f); }
                *(u32x2*)rowp = (u32x2){pk4_fp8(a[0], a[1], a[2], a[3]), pk4_fp8(a[4], a[5], a[6], a[7])}; }
    }
};

template <class Epi, class Sched, bool GATHER, bool FP8 = false>
__device__ __forceinline__ void gemm_phase(LAS unsigned char* lds, const Sched& S, const Epi& E) {
    const int tid = threadIdx.x, wid = __builtin_amdgcn_readfirstlane(tid >> 6), lane = tid & 63, wr = wid >> 2, wc = wid & 3, fr = lane & 15, fq = lane >> 4;
    constexpr int RP = FP8 ? 2048 : 4096, nt = RP / 128;
    unsigned voffA[2][2], voffB[2];
#pragma unroll
    for (int i = 0; i < 2; ++i) { int R, C; stage_rc(tid * 16 + i * 8192, R, C); const int Rb = Epi::PERM ? ((R & ~31) + perm32(R & 31)) : R;
        voffA[0][i] = (unsigned)(R * RP + C * 2); voffA[1][i] = (unsigned)((R + HALF) * RP + C * 2); voffB[i] = (unsigned)(Rb * RP + C * 2); }
    constexpr size_t kstep = (size_t)(BK * 2);
    constexpr size_t hstep = (size_t)HALF * RP;
    const unsigned ldsw = (unsigned)wid * 1024u;
    const int aoff = lds_byte(wr * 64 + fr, fq * 8), boff = lds_byte(wc * 32 + fr, fq * 8);
#define PG8_SA(b, h) (((b) * 2 + (h)) * HTB)
#define PG8_SB(b, h) ((4 + (b) * 2 + (h)) * HTB)
#define PG8_STAGE(bufoff, gbase, voff) do { _Pragma("unroll") for (int _i = 0; _i < 2; ++_i) \
        __builtin_amdgcn_global_load_lds((const unsigned*)((const char*)(gbase) + (voff)[_i]), (LAS unsigned*)(lds + (bufoff) + ldsw + _i * 8192), 16, 0, 0); } while (0)
#define PG8_CAT(p) __builtin_shufflevector(*(const LAS i32x4*)(p), *(const LAS i32x4*)((p) + 1024), 0, 1, 2, 3, 4, 5, 6, 7)
#define PG8_LDA(dst, b, h) do { _Pragma("unroll") for (int m = 0; m < 4; ++m) dst[m] = PG8_CAT(lds + PG8_SA(b, h) + aoff + m * 2048); } while (0)
#define PG8_LDB(dst, b, h) do { _Pragma("unroll") for (int n = 0; n < 2; ++n) dst[n] = PG8_CAT(lds + PG8_SB(b, h) + boff + n * 2048); } while (0)
#define PG8_HALF(v, k) __builtin_bit_cast(bf16x8, (k) ? __builtin_shufflevector(v, v, 4, 5, 6, 7) : __builtin_shufflevector(v, v, 0, 1, 2, 3))
#define PG8_MMA(ai, bj, At, Bt) do { __builtin_amdgcn_s_setprio(1); _Pragma("unroll") for (int m = 0; m < 4; ++m) _Pragma("unroll") for (int n = 0; n < 2; ++n) { \
        if constexpr (FP8) asm volatile("v_mfma_scale_f32_16x16x128_f8f6f4 %0, %1, %2, %0, %3, %4 op_sel_hi:[0,0,0]" : "+v"(acc[ai][bj][m][n]) : "v"(Bt[n]), "v"(At[m]), "v"(scw), "v"(sca));   \
        else { _Pragma("unroll") for (int k = 0; k < 2; ++k) acc[ai][bj][m][n] = __builtin_amdgcn_mfma_f32_16x16x32_bf16(PG8_HALF(Bt[n], k), PG8_HALF(At[m], k), acc[ai][bj][m][n], 0, 0, 0); } } \
        __builtin_amdgcn_s_setprio(0); } while (0)
#define PG8_WAIT_V(n) asm volatile("s_waitcnt vmcnt(" #n ")" ::: "memory")
#define PG8_WAIT_L(n) asm volatile("s_waitcnt lgkmcnt(" #n ")" ::: "memory")
#define PG8_BAR __builtin_amdgcn_s_barrier()
#define PG8_SCHED __builtin_amdgcn_sched_barrier(0)
#define PG8_GATHER(dst, u) do { _Pragma("unroll") for (int _i = 0; _i < 2; ++_i) { int _R, _C; stage_rc(tid * 16 + _i * 8192, _R, _C); _Pragma("unroll") for (int _h = 0; _h < 2; ++_h) { \
        const int _idx = _h * HALF + _R; const int _t = ((u).ui < 15) ? S.tokl[(u).ui * 256 + _idx] : ((_idx < (u).cnt) ? (u).tok[_idx] : 0);     \
        dst[_h][_i] = (unsigned)(_t * RP + _C * 2); } } } while (0)
    Unit cur, nxt; int ui = 0;
    if (!S.next(0, cur)) return;
    f32x4 acc[2][2][4][2];
#pragma unroll
    for (int a = 0; a < 2; ++a)
#pragma unroll
        for (int b = 0; b < 2; ++b)
#pragma unroll
            for (int m = 0; m < 4; ++m)
#pragma unroll
                for (int n = 0; n < 2; ++n) acc[a][b][m][n] = (f32x4){0.f, 0.f, 0.f, 0.f};
    int scw = 0x79797979, sca = 0x7f7f7f7f;
    asm volatile("" : "+v"(scw), "+v"(sca));
    i32x8 At[4], B0[2], B1[2];
    const char* cA = cur.A; const char* cB = cur.B;
    S.a_ready(cur);
    if constexpr (GATHER) { PG8_GATHER(voffA, cur); }
    PG8_STAGE(PG8_SB(0, 0), cB, voffB); PG8_STAGE(PG8_SB(0, 1), cB + hstep, voffB); PG8_STAGE(PG8_SA(0, 0), cA, voffA[0]); PG8_STAGE(PG8_SA(0, 1), cA, voffA[1]);
    if (wr == 1) PG8_BAR;
    PG8_WAIT_V(2); PG8_BAR;
    PG8_STAGE(PG8_SB(1, 0), cB + kstep, voffB); PG8_STAGE(PG8_SA(1, 0), cA + kstep, voffA[0]); PG8_STAGE(PG8_SB(1, 1), cB + hstep + kstep, voffB);
    PG8_WAIT_V(6); PG8_BAR;
    for (;;) {
        const bool has_next = S.next(ui + 1, nxt);
        const char* nA = has_next ? nxt.A : cA; const char* nB = has_next ? nxt.B : cB;
        for (int t = 0; t < nt; t += 2) {
            const bool last = (t == nt - 2);
            const char* a1 = cA + (size_t)(t + 1) * kstep;
            const char* a2 = last ? nA : cA + (size_t)(t + 2) * kstep; const char* b2 = last ? nB : cB + (size_t)(t + 2) * kstep;
            const char* a3 = a2 + kstep; const char* b3 = b2 + kstep;
            if (last && has_next) S.a_ready(nxt);
            PG8_LDB(B0, 0, 0); PG8_LDB(B1, 0, 1); PG8_SCHED; PG8_LDA(At, 0, 0); PG8_STAGE(PG8_SA(1, 1), a1, voffA[1]);
            PG8_WAIT_V(8); PG8_WAIT_L(0); PG8_BAR; PG8_MMA(0, 0, At, B0); PG8_MMA(0, 1, At, B1); PG8_BAR; PG8_SCHED;
            if constexpr (GATHER) { if (last && has_next) { PG8_GATHER(voffA, nxt); } }
            PG8_LDA(At, 0, 1); PG8_STAGE(PG8_SB(0, 0), b2, voffB); PG8_STAGE(PG8_SB(0, 1), b2 + hstep, voffB); PG8_STAGE(PG8_SA(0, 0), a2, voffA[0]);
            PG8_WAIT_V(8); PG8_WAIT_L(0); PG8_BAR; PG8_MMA(1, 0, At, B0); PG8_MMA(1, 1, At, B1); PG8_BAR; PG8_SCHED;
            PG8_LDB(B0, 1, 0); PG8_LDB(B1, 1, 1); PG8_SCHED; PG8_LDA(At, 1, 0); PG8_STAGE(PG8_SA(0, 1), a2, voffA[1]);
            PG8_WAIT_V(8); PG8_WAIT_L(0); PG8_BAR; PG8_MMA(0, 0, At, B0); PG8_MMA(0, 1, At, B1); PG8_BAR; PG8_SCHED;
            PG8_LDA(At, 1, 1); PG8_STAGE(PG8_SB(1, 0), b3, voffB); PG8_STAGE(PG8_SB(1, 1), b3 + hstep, voffB); PG8_STAGE(PG8_SA(1, 0), a3, voffA[0]);
            PG8_WAIT_V(8); PG8_WAIT_L(0); PG8_BAR; PG8_MMA(1, 0, At, B0); PG8_MMA(1, 1, At, B1); PG8_BAR; PG8_SCHED;
        }
        if (wr == 0) PG8_BAR;
        if constexpr (FP8) { asm volatile("s_nop 15\n\ts_nop 15" ::: "memory");
#pragma unroll
            for (int a_ = 0; a_ < 2; ++a_)
#pragma unroll
                for (int b_ = 0; b_ < 2; ++b_)
#pragma unroll
                    for (int m_ = 0; m_ < 4; ++m_)
#pragma unroll
                        for (int n_ = 0; n_ < 2; ++n_) asm volatile("" : "+v"(acc[a_][b_][m_][n_])); }
        E(acc, cur, wr, wc, fr, fq);
        if (!has_next) break;
#pragma unroll
        for (int a = 0; a < 2; ++a)
#pragma unroll
            for (int b = 0; b < 2; ++b)
#pragma unroll
                for (int m = 0; m < 4; ++m)
#pragma unroll
                    for (int n = 0; n < 2; ++n) acc[a][b][m][n] = (f32x4){0.f, 0.f, 0.f, 0.f};
        cur = nxt; cA = nA; cB = nB; ++ui;
        if (wr == 1) PG8_BAR;
    }
    PG8_WAIT_V(0);
    PG8_BAR;
#undef PG8_SA
#undef PG8_SB
#undef PG8_STAGE
#undef PG8_LDA
#undef PG8_CAT
#undef PG8_HALF
#undef PG8_LDB
#undef PG8_MMA
#undef PG8_WAIT_V
#undef PG8_WAIT_L
#undef PG8_BAR
#undef PG8_SCHED
#undef PG8_GATHER
}
}

#define XB_TMO      128
#define XB_XCNT(j)  (256  + 64 * (j))
#define XB_XSUB(j)  (1280 + 64 * (j))
#define XB_XGEN(j)  (2304 + 64 * (j))
#define XB_TOP      3328
#define XB_TOPGEN   3392
#define XCD_BAR_WORDS 3456
#define XB_SPIN_CAP (1u << 18)
__device__ __forceinline__ unsigned xb_ld(unsigned* p)              { return __hip_atomic_load(p, __ATOMIC_RELAXED, __HIP_MEMORY_SCOPE_AGENT); }
__device__ __forceinline__ unsigned xb_add(unsigned* p, unsigned v) { return __hip_atomic_fetch_add(p, v, __ATOMIC_RELAXED, __HIP_MEMORY_SCOPE_AGENT); }
__device__ __forceinline__ unsigned xb_xcc_id() { return (unsigned)__builtin_amdgcn_s_getreg((3 << 11) | 20) & 0xFu; }
#define XB_SPIN(cond, bar) do { unsigned _sp = 0; while (cond) { __builtin_amdgcn_s_sleep(1); \
    if ((++_sp & 255u) == 0u) { if (xb_ld(&(bar)[XB_TMO])) break; if (_sp > XB_SPIN_CAP) { atomicAdd(&(bar)[XB_TMO], 1u); break; } } } } while (0)
struct XcdBarrier { unsigned* bar; unsigned x; volatile LAS unsigned* st; };
__device__ __forceinline__ XcdBarrier xcd_barrier_post(unsigned* bar, volatile LAS unsigned* st) {
    XcdBarrier b; b.bar = bar; b.x = xb_xcc_id(); b.st = st;
    if (threadIdx.x == 0) (void)xb_add(&bar[XB_XCNT(b.x)], 1u);
    return b;
}
__device__ __forceinline__ void xcd_barrier_complete(unsigned* bar, unsigned x, unsigned& nloc, unsigned& nx) {
    const unsigned G = gridDim.x * gridDim.y * gridDim.z;
    unsigned sum, cnt, mine, sp = 0u;
    for (;;) {
        sum = 0u; cnt = 0u; mine = 0u;
#pragma unroll
        for (unsigned j = 0; j < 16; ++j) { const unsigned c = xb_ld(&bar[XB_XCNT(j)]); sum += c; cnt += (c > 0u) ? 1u : 0u; mine = (j == x) ? c : mine; }
        if (sum == G) break;
        __builtin_amdgcn_s_sleep(1);
        if ((++sp & 255u) == 0u) { if (xb_ld(&bar[XB_TMO])) break; if (sp > XB_SPIN_CAP) { atomicAdd(&bar[XB_TMO], 1u); break; } }
    }
    nloc = mine > 0u ? mine : 1u; nx = cnt > 0u ? cnt : 1u;
}
__device__ __forceinline__ void xcd_barrier(const XcdBarrier& b) {
    asm volatile("s_waitcnt vmcnt(0)" ::: "memory");
    __syncthreads();
    if (threadIdx.x == 0) {
        unsigned* bar = b.bar;
        __builtin_amdgcn_s_waitcnt(0);
        unsigned nloc = b.st[0], nx = b.st[1];
        if (nloc == 0u) { xcd_barrier_complete(bar, b.x, nloc, nx); b.st[0] = nloc; b.st[1] = nx; }
        const unsigned old = xb_add(&bar[XB_XSUB(b.x)], 1u);
        const unsigned gen = old / nloc;
        if (old + 1u == (gen + 1u) * nloc) {
            __builtin_amdgcn_fence(__ATOMIC_RELEASE, "agent");
            asm volatile("s_waitcnt vmcnt(0)" ::: "memory");
            const unsigned og = xb_add(&bar[XB_TOP], 1u);
            const unsigned tg = og / nx;
            if (og + 1u == (tg + 1u) * nx) xb_add(&bar[XB_TOPGEN], 1u);
            else XB_SPIN(xb_ld(&bar[XB_TOPGEN]) == tg, bar);
            __builtin_amdgcn_fence(__ATOMIC_ACQUIRE, "agent");
            xb_add(&bar[XB_XGEN(b.x)], 1u);
            asm volatile("s_waitcnt vmcnt(0)" ::: "memory");
        } else {
            XB_SPIN(xb_ld(&bar[XB_XGEN(b.x)]) == gen, bar);
            __builtin_amdgcn_fence(__ATOMIC_ACQUIRE, "agent");
            asm volatile("s_waitcnt vmcnt(0)" ::: "memory");
        }
    }
    __syncthreads();
}

struct Args {
    const float* in[28];
    float* out; unsigned char* ws;
    int ph_lo, ph_hi, li, pad;
};
enum { I_X = 0, I_MEM, I_NORM_MIX, I_W_IN, I_CONV_W, I_CONV_B, I_DT_BIAS, I_A_LOG, I_D_SKIP, I_SSD_NORM, I_POOL_W, I_POOL_SCALE, I_W_OUT, I_NORM_XATTN, I_NORM_MEM,
       I_W_Q, I_W_KV, I_W_O, I_NORM_FFN, I_W_ROUTER, I_B_ROUTER, I_W_GATE, I_B_GATE, I_W_UP, I_B_UP, I_W_DOWN, I_B_DOWN, I_NORM_FINAL };

template <int MT, int NT>
__device__ __forceinline__ void wave_mma(f32x4 (&acc)[MT][NT], const LAS bf16* A, int lda, const LAS bf16* Bt, int ldb, int K, int lane) {
    const int fr = lane & 15, fq = lane >> 4;
    for (int k0 = 0; k0 < K; k0 += 32) {
        bf16x8 a[MT], b[NT];
#pragma unroll
        for (int m = 0; m < MT; ++m) a[m] = *(const LAS bf16x8*)(A + (m * 16 + fr) * lda + k0 + fq * 8);
#pragma unroll
        for (int n = 0; n < NT; ++n) b[n] = *(const LAS bf16x8*)(Bt + (n * 16 + fr) * ldb + k0 + fq * 8);
#pragma unroll
        for (int m = 0; m < MT; ++m)
#pragma unroll
            for (int n = 0; n < NT; ++n) acc[m][n] = __builtin_amdgcn_mfma_f32_16x16x32_bf16(b[n], a[m], acc[m][n], 0, 0, 0);
    }
}
__device__ __forceinline__ void tile_g2l(LAS bf16* dst, int ldd, const bf16* src, size_t lds_, int rows, int cols, int tid) {
    const int vpr = cols >> 3, nv = rows * vpr;
    for (int i = tid; i < nv; i += NTHREADS) { const int r = i / vpr, c = i - r * vpr; *(LAS u32x4*)(dst + r * ldd + c * 8) = *(const u32x4*)(src + (size_t)r * lds_ + c * 8); }
}

constexpr int CW_RDY = 24576;
constexpr int CW_TMO = 2;
constexpr int CONV_RDY_TARGET = 1024;
struct ConvItem { const float* sp; unsigned char* dst; unsigned nbytes; int drow0, kb2; };
__device__ __forceinline__ void conv_decode(const Args& a, int it, int lane, ConvItem& c) {
    unsigned char* ws = a.ws; constexpr int GU_ITEMS = NE * 1024; const float* src; int nb;
    if (it < GU_ITEMS) { const int e = it >> 10, r = it & 1023, up = r >> 9, r2 = r & 511; c.kb2 = r2 >> 5; nb = r2 & 31;
        src = (up ? a.in[I_W_UP] : a.in[I_W_GATE]) + (size_t)e * 2048 * 2048; c.dst = ws + WS_WGU + (size_t)e * 4096 * 2048; c.nbytes = 4096u * 2048u;
        const int n0 = nb * 64; c.drow0 = (n0 >> 7) * 256 + (n0 & 127) + (up ? 128 : 0); }
    else { const int q = it - GU_ITEMS; const int e = q >> 9, r2 = q & 511; c.kb2 = r2 >> 5; nb = r2 & 31;
        src = a.in[I_W_DOWN] + (size_t)e * 2048 * 2048; c.dst = ws + WS_WD + (size_t)e * 2048 * 2048; c.nbytes = 2048u * 2048u; c.drow0 = nb * 64; }
    c.sp = src + (size_t)(c.kb2 * 128) * 2048 + nb * 64 + lane;
}
#define CONV_LOAD(v, c, h) do { _Pragma("unroll") for (int i_ = 0; i_ < 64; ++i_) v[i_] = __builtin_nontemporal_load((c).sp + (size_t)((h) * 64 + i_) * 2048); } while (0)
#define CONV_PACK(v, t) do { _Pragma("unroll") for (int q_ = 0; q_ < 4; ++q_) { \
        t[q_].x = pk4_fp8(v[16 * q_ + 0] * 64.0f, v[16 * q_ + 1] * 64.0f, v[16 * q_ + 2] * 64.0f, v[16 * q_ + 3] * 64.0f); \
        t[q_].y = pk4_fp8(v[16 * q_ + 4] * 64.0f, v[16 * q_ + 5] * 64.0f, v[16 * q_ + 6] * 64.0f, v[16 * q_ + 7] * 64.0f); \
        t[q_].z = pk4_fp8(v[16 * q_ + 8] * 64.0f, v[16 * q_ + 9] * 64.0f, v[16 * q_ + 10] * 64.0f, v[16 * q_ + 11] * 64.0f); \
        t[q_].w = pk4_fp8(v[16 * q_ + 12] * 64.0f, v[16 * q_ + 13] * 64.0f, v[16 * q_ + 14] * 64.0f, v[16 * q_ + 15] * 64.0f); } } while (0)
__device__ __forceinline__ void moe_convert(const Args& a, LAS unsigned char* lds, int cw, int NCW, int lane, int wave) {
    constexpr int ALL_ITEMS = NE * 1536;
    LAS unsigned char* my = lds + wave * 9216;
    float va[64], vb[64]; ConvItem c;
    int it = cw;
    if (it < ALL_ITEMS) { conv_decode(a, it, lane, c); CONV_LOAD(va, c, 0); CONV_LOAD(vb, c, 1); }
    while (it < ALL_ITEMS) {
        u32x4 hold[4];
        CONV_PACK(va, hold);
#pragma unroll
        for (int q = 0; q < 4; ++q) asm volatile("" : "+v"(hold[q]));
        unsigned char* dstp = c.dst; const unsigned nbytes = c.nbytes; const unsigned voff = (unsigned)((c.drow0 + (lane >> 3)) * 2048 + c.kb2 * 128 + 16 * (lane & 7));
        it += NCW;
        if (it < ALL_ITEMS) { conv_decode(a, it, lane, c); CONV_LOAD(va, c, 0); }
        u32x4 t[4];
        CONV_PACK(vb, t);
#pragma unroll
        for (int q = 0; q < 4; ++q) { *(LAS u32x4*)(my + lane * 144 + 16 * q) = hold[q]; *(LAS u32x4*)(my + lane * 144 + 64 + 16 * q) = t[q]; }
        LDS_WAIT(); __builtin_amdgcn_wave_barrier();
        u32x4 o[8];
#pragma unroll
        for (int j = 0; j < 8; ++j) o[j] = *(const LAS u32x4*)(my + (8 * j + (lane >> 3)) * 144 + 16 * (lane & 7));
        LDS_WAIT(); __builtin_amdgcn_wave_barrier();
        const __amdgpu_buffer_rsrc_t rs = __builtin_amdgcn_make_buffer_rsrc((void*)dstp, 0, nbytes, 0x00020000);
#pragma unroll
        for (int j = 0; j < 8; ++j) __builtin_amdgcn_raw_buffer_store_b128(o[j], rs, voff + (unsigned)(8 * j * 2048), 0, 0);
        if (it < ALL_ITEMS) { CONV_LOAD(vb, c, 1); }
    }
}

__device__ __forceinline__ void transpose_block(const float* W, int ldw, int k0, bf16* dstrow, int Kd, int lane, int nvalid, LAS unsigned char* my) {
    float v[64];
    const float* s = W + (size_t)k0 * ldw + (lane < nvalid ? lane : 0);
#pragma unroll
    for (int i = 0; i < 64; ++i) v[i] = __builtin_nontemporal_load(s + (size_t)i * ldw);
#pragma unroll
    for (int j = 0; j < 8; ++j) { u32x4 o; o.x = pk2(v[8 * j], v[8 * j + 1]); o.y = pk2(v[8 * j + 2], v[8 * j + 3]); o.z = pk2(v[8 * j + 4], v[8 * j + 5]); o.w = pk2(v[8 * j + 6], v[8 * j + 7]);
        *(LAS u32x4*)(my + lane * 144 + 16 * j) = o; }
    LDS_WAIT(); __builtin_amdgcn_wave_barrier();
#pragma unroll
    for (int j = 0; j < 8; ++j) { const int r = 8 * j + (lane >> 3); const u32x4 o = *(const LAS u32x4*)(my + r * 144 + 16 * (lane & 7));
        if (r < nvalid) *(u32x4*)(dstrow + (size_t)r * Kd + k0 + 8 * (lane & 7)) = o; }
    LDS_WAIT(); __builtin_amdgcn_wave_barrier();
}
struct ConvDesc { const float* src; bf16* dst; int ldw, K, srccol0, ncb, nexp, mode; size_t src_es, dst_es; };

__device__ __forceinline__ void conv_matrix(const ConvDesc& d, int gw, int NGW, int lane, LAS unsigned char* my) {
    const int nkb = d.K / 64, per = nkb * d.ncb, total = per * d.nexp;
    for (int it = gw; it < total; it += NGW) {
        const int e = it / per, r = it - e * per, kb = r / d.ncb, nb = r - kb * d.ncb;
        const int n0 = nb * 64;
        int drow = n0;
        if (d.mode) drow = (n0 >> 7) * 256 + (n0 & 127) + (d.mode == 2 ? 128 : 0);
        transpose_block(d.src + (size_t)e * d.src_es + d.srccol0 + n0, d.ldw, kb * 64, d.dst + (size_t)e * d.dst_es + (size_t)drow * d.K, d.K, lane, 64, my);
    }
}

#if defined(P0_PROBE) && P0_PROBE < 3
__device__ __forceinline__ void p0_probe(const Args& a, int gw, int NGW, int lane) {
    float acc = 0.f;
#if P0_PROBE == 1
    constexpr int ALL_ITEMS = NE * 1024 + NE * 512;
    for (int it = gw; it < ALL_ITEMS; it += NGW) {
        int e, kb, nb; const float* src;
        if (it < NE * 1024) { e = it >> 10; const int r = it & 1023, up = r >> 9, r2 = r & 511; kb = r2 >> 4; nb = r2 & 15; src = (up ? a.in[I_W_UP] : a.in[I_W_GATE]) + (size_t)e * 2048 * 2048; }
        else { const int q = it - NE * 1024; e = q >> 9; const int r2 = q & 511; kb = r2 >> 4; nb = r2 & 15; src = a.in[I_W_DOWN] + (size_t)e * 2048 * 2048; }
        const f32x2* sp = (const f32x2*)(src + (size_t)(kb * 64) * 2048 + nb * 128) + lane;
        f32x2 v[64];
#pragma unroll
        for (int i = 0; i < 64; ++i) v[i] = sp[(size_t)i * 1024];
#pragma unroll
        for (int i = 0; i < 64; ++i) acc += v[i].x + v[i].y;
    }
#elif P0_PROBE == 2
    constexpr int ALL_ITEMS = NE * 3 * 64 * 8;
    for (int it0 = gw; it0 < NE * 3 * 8; it0 += NGW) {
        const int mat = it0 >> 3, strip = it0 & 7; const int e = mat / 3, wh = mat % 3;
        const float* src = (wh == 0 ? a.in[I_W_GATE] : wh == 1 ? a.in[I_W_UP] : a.in[I_W_DOWN]) + (size_t)e * 2048 * 2048 + strip * 256;
        for (int kb = 0; kb < 64; ++kb) {
            const f32x4* sp = (const f32x4*)(src + (size_t)(kb * 32) * 2048) + lane;
            f32x4 v[32];
#pragma unroll
            for (int i = 0; i < 32; ++i) v[i] = sp[(size_t)i * 512];
#pragma unroll
            for (int i = 0; i < 32; ++i) acc += (v[i].x + v[i].y) + (v[i].z + v[i].w);
        }
    }
    (void)ALL_ITEMS;
#endif
    if (acc == 1.2345e-30f) ((float*)(a.ws + WS_CTL))[20] = acc;
}
#endif
__device__ __forceinline__ void p0_prologue(const Args& a, LAS unsigned char* lds, int tid, int lane, int wave, int vcu, int G) {
    unsigned char* ws = a.ws;
    const int gw = vcu * NWAVES + wave, NGW = G * NWAVES;
#ifdef P0_PROBE
    if (a.pad == 1) { p0_probe(a, gw, NGW, lane); return; }
#endif
    {
        ConvDesc d;
        d = ConvDesc{a.in[I_W_IN], (bf16*)(ws + WS_WIN), DIN, 2048, 0, 48, 1, 0, 0, 0}; conv_matrix(d, gw, NGW, lane, lds + wave * 9216);
        d = ConvDesc{a.in[I_W_IN], (bf16*)(ws + WS_WIN) + (size_t)3072 * 2048, DIN, 2048, 3088, 16, 1, 0, 0, 0}; conv_matrix(d, gw, NGW, lane, lds + wave * 9216);
        d = ConvDesc{a.in[I_W_OUT], (bf16*)(ws + WS_WOUT), 2048, 2048, 0, 32, 1, 0, 0, 0}; conv_matrix(d, gw, NGW, lane, lds + wave * 9216);
        d = ConvDesc{a.in[I_W_Q], (bf16*)(ws + WS_WQ), 2048, 2048, 0, 32, 1, 0, 0, 0}; conv_matrix(d, gw, NGW, lane, lds + wave * 9216);
        d = ConvDesc{a.in[I_W_KV], (bf16*)(ws + WS_WK), 4096, 2048, 0, 32, 1, 0, 0, 0}; conv_matrix(d, gw, NGW, lane, lds + wave * 9216);
        d = ConvDesc{a.in[I_W_KV], (bf16*)(ws + WS_WV), 4096, 2048, 2048, 32, 1, 0, 0, 0}; conv_matrix(d, gw, NGW, lane, lds + wave * 9216);
        d = ConvDesc{a.in[I_W_O], (bf16*)(ws + WS_WO), 2048, 2048, 0, 32, 1, 0, 0, 0}; conv_matrix(d, gw, NGW, lane, lds + wave * 9216);
        d = ConvDesc{a.in[I_POOL_W], (bf16*)(ws + WS_PW), 256, 256, 0, 4, 4, 0, (size_t)256 * 256, (size_t)256 * 256}; conv_matrix(d, gw, NGW, lane, lds + wave * 9216);
        moe_convert(a, lds, gw, NGW, lane, wave);
        __syncthreads();
        for (int kb = gw; kb < 32; kb += NGW) transpose_block(a.in[I_W_ROUTER], 32, kb * 64, (bf16*)(ws + WS_WR), 2048, lane, 32, lds + wave * 9216);
    }
    __syncthreads();
    constexpr int WP = 2052;
    LAS float* wdt = (LAS float*)lds;
    {
        const float* w_in = a.in[I_W_IN];
        for (int i = tid; i < 2048 * 16; i += NTHREADS) { const int k = i >> 4, h = i & 15; wdt[h * WP + k] = w_in[(size_t)k * DIN + 3072 + h]; }
    }
    __syncthreads();
    {
        const float* x = a.in[I_X]; const float* nw = a.in[I_NORM_MIX];
        bf16* hn = (bf16*)(ws + WS_HN); float* dtraw = (float*)(ws + WS_DTRAW);
        f32x4 wv[8];
#pragma unroll
        for (int j = 0; j < 8; ++j) wv[j] = ((const f32x4*)nw)[lane + 64 * j];
        for (int m = gw; m < T; m += NGW) {
            const f32x4* xr = (const f32x4*)(x + (size_t)m * D) + lane;
            f32x4 v[8]; float ss = 0.f;
#pragma unroll
            for (int j = 0; j < 8; ++j) { v[j] = xr[64 * j]; ss += (v[j].x * v[j].x + v[j].y * v[j].y) + (v[j].z * v[j].z + v[j].w * v[j].w); }
            const float rstd = rsqrtf(wave_sum(ss) * (1.f / D) + EPS);
            u32x2* o8 = (u32x2*)(hn + (size_t)m * D) + lane;
#pragma unroll
            for (int j = 0; j < 8; ++j) { v[j] = v[j] * rstd * wv[j]; u32x2 w; w.x = pk2(v[j].x, v[j].y); w.y = pk2(v[j].z, v[j].w); o8[64 * j] = w; }
            float res = 0.f;
#pragma unroll 1
            for (int h = 0; h < 16; ++h) {
                const LAS f32x4* wr = (const LAS f32x4*)(wdt + h * WP) + lane; float p = 0.f;
#pragma unroll
                for (int j = 0; j < 8; ++j) { const f32x4 w4 = wr[64 * j]; p += (v[j].x * w4.x + v[j].y * w4.y) + (v[j].z * w4.z + v[j].w * w4.w); }
                p = wave_sum(p); if (lane == h) res = p;
            }
            if (lane < 16) dtraw[(size_t)m * 16 + lane] = res;
        }
    }
    {
        const float* x = a.in[I_MEM]; const float* nw = a.in[I_NORM_MEM]; bf16* o = (bf16*)(ws + WS_MEMN);
        for (int m = gw; m < NB * NMEM; m += NGW) {
            const f32x4* xr = (const f32x4*)(x + (size_t)m * D) + lane;
            f32x4 v[8]; float ss = 0.f;
#pragma unroll
            for (int j = 0; j < 8; ++j) { v[j] = xr[64 * j]; ss += (v[j].x * v[j].x + v[j].y * v[j].y) + (v[j].z * v[j].z + v[j].w * v[j].w); }
            const float rstd = rsqrtf(wave_sum(ss) * (1.f / D) + EPS);
            u32x2* o8 = (u32x2*)(o + (size_t)m * D) + lane;
#pragma unroll
            for (int j = 0; j < 8; ++j) { const f32x4 w4 = ((const f32x4*)nw)[lane + 64 * j]; v[j] = v[j] * rstd * w4; u32x2 w; w.x = pk2(v[j].x, v[j].y); w.y = pk2(v[j].z, v[j].w); o8[64 * j] = w; }
        }
    }
}

__device__ __forceinline__ f32x4 ld_row4(const bf16* row, int lane, int j) { const u32x2 t = ((const u32x2*)row)[lane + 64 * j]; return (f32x4){bflo(t.x), bfhi(t.x), bflo(t.y), bfhi(t.y)}; }
__device__ __forceinline__ void rms_rows_bf16(const bf16* src, const float* nw, bf16* o, int rows, int gw, int NGW, int lane) {
    f32x4 wv[8];
#pragma unroll
    for (int j = 0; j < 8; ++j) wv[j] = ((const f32x4*)nw)[lane + 64 * j];
    for (int m = gw; m < rows; m += NGW) {
        const bf16* xr = src + (size_t)m * D;
        f32x4 v[8]; float ss = 0.f;
#pragma unroll
        for (int j = 0; j < 8; ++j) { v[j] = ld_row4(xr, lane, j); ss += (v[j].x * v[j].x + v[j].y * v[j].y) + (v[j].z * v[j].z + v[j].w * v[j].w); }
        const float rstd = rsqrtf(wave_sum(ss) * (1.f / D) + EPS);
        u32x2* o8 = (u32x2*)(o + (size_t)m * D) + lane;
#pragma unroll
        for (int j = 0; j < 8; ++j) { v[j] = v[j] * rstd * wv[j]; u32x2 w; w.x = pk2(v[j].x, v[j].y); w.y = pk2(v[j].z, v[j].w); o8[64 * j] = w; }
    }
}

struct DenseSched {
    const char* A; const char* B; char* O; int ldc; int nM, nN, nwg, G, c; const LAS int* tokl = nullptr;
    __device__ __forceinline__ void a_ready(const pg8::Unit&) const {}
    __device__ __forceinline__ void decode(int L, int& pm, int& pn) const {
        int wgid = L; { const int q = nwg / 8, r = nwg % 8, xcd = wgid % 8, off = wgid / 8; wgid = (xcd < r ? xcd * (q + 1) : r * (q + 1) + (xcd - r) * q) + off; }
        const int nig = 8 * nN, gid = wgid / nig, fm = gid * 8, gsz = (nM - fm) < 8 ? (nM - fm) : 8;
        pm = fm + ((wgid % nig) % gsz); pn = (wgid % nig) / gsz;
    }
    __device__ __forceinline__ bool next(int i, pg8::Unit& u) const {
        const int L = i * G + c; if (L >= nwg) return false;
        int pm, pn; decode(L, pm, pn);
        u.A = A + (size_t)pm * 256 * 4096; u.B = B + (size_t)pn * 256 * 4096; u.O = O; u.ldc = ldc; u.row0 = pm * 256; u.col0 = pn * 256; u.e = 0; u.cnt = 0; u.tok = nullptr; u.ui = i;
        return true;
    }
};
struct P1Sched {
    DenseSched inproj; const char* memn; const char* wk; const char* wv; char* kmem; char* vt; int G, c; const LAS int* tokl = nullptr;
    __device__ __forceinline__ void a_ready(const pg8::Unit&) const {}
    __device__ __forceinline__ bool next(int i, pg8::Unit& u) const {
        const int L = i * G + c;
        if (L < 512) return inproj.next(i, u);
        const int r = L - 512; if (r >= 32) return false;
        u.e = 0; u.cnt = 0; u.tok = nullptr; u.ui = i;
        if (r < 16) { const int pm = r & 1, pn = r >> 1; u.A = memn + (size_t)pm * 256 * 4096; u.B = wk + (size_t)pn * 256 * 4096; u.O = kmem; u.ldc = 2048; u.row0 = pm * 256; u.col0 = pn * 256; }
        else { const int q = r - 16, pm = q >> 1, pn = q & 1; u.A = wv + (size_t)pm * 256 * 4096; u.B = memn + (size_t)pn * 256 * 4096; u.O = vt; u.ldc = 512; u.row0 = pm * 256; u.col0 = pn * 256; }
        return true;
    }
};
struct MoeSched {
    const LAS int* tstart; const int* cnt; const int* tok; const char* A; const char* B; char* O; int nN, colw, G, c; size_t b_es; bool gather; unsigned* rdy; const LAS int* tokl;
    __device__ __forceinline__ void a_ready(const pg8::Unit& u) const {
        if (rdy == nullptr) return;
        if (threadIdx.x < 64) {
            unsigned* tmo = rdy - 24576 + 2;
            const unsigned long long t0 = __builtin_amdgcn_s_memrealtime(); unsigned polls = 0;
            while ((unsigned)__builtin_amdgcn_readfirstlane(__hip_atomic_load(rdy + 64 * u.e, __ATOMIC_RELAXED, __HIP_MEMORY_SCOPE_AGENT)) < 1024u) {
                if ((++polls & 255u) == 0u && __builtin_amdgcn_readfirstlane(__hip_atomic_load(tmo, __ATOMIC_RELAXED, __HIP_MEMORY_SCOPE_AGENT)) != 0u) break;
                if (__builtin_amdgcn_s_memrealtime() - t0 > 2000000ull) { if (threadIdx.x == 0) __hip_atomic_store(tmo, 1u, __ATOMIC_RELAXED, __HIP_MEMORY_SCOPE_AGENT); break; }
                __builtin_amdgcn_s_sleep(2); }
            __builtin_amdgcn_fence(__ATOMIC_ACQUIRE, "agent");
            asm volatile("s_waitcnt vmcnt(0)" ::: "memory");
        }
        asm volatile("" ::: "memory"); __builtin_amdgcn_s_barrier(); asm volatile("" ::: "memory");
    }
    __device__ __forceinline__ bool next(int i, pg8::Unit& u) const {
        const int L = i * G + c; const int ntile = tstart[NE];
        if (L >= ntile * nN) return false;
        const int mg = L / nN, pn = L - mg * nN;
        int e = 0;
#pragma unroll 1
        for (int j = 1; j < NE; ++j) e += (tstart[j] <= mg) ? 1 : 0;
        const int mt = mg - tstart[e];
        u.e = e; u.cnt = cnt[64 * e] - mt * 256; u.tok = tok + e * 8192 + mt * 256; u.ui = i;
        u.A = gather ? A : A + (size_t)mg * 256 * 2048; u.B = B + (size_t)e * b_es + (size_t)pn * 256 * 2048; u.O = O; u.ldc = 2048; u.row0 = mg * 256; u.col0 = pn * colw;
        return true;
    }
};

constexpr int LD1 = 136;
__device__ __forceinline__ void ssd_chunk_unit(const Args& a, LAS unsigned char* lds, int unit, int tid, int lane, int wave) {
    unsigned char* ws = a.ws;
    const int g = unit & 3, c = (unit >> 2) & 31, b = unit >> 7;
    const int t0 = b * SEQ + c * CHUNK;
    const bf16* P = (const bf16*)(ws + WS_P);
    const float* conv_w = a.in[I_CONV_W]; const float* conv_b = a.in[I_CONV_B];
    LAS bf16* Cm = (LAS bf16*)lds;
    LAS bf16* Bm = (LAS bf16*)(lds + 34816);
    LAS bf16* BmT = (LAS bf16*)(lds + 69632);
    LAS bf16* XT = (LAS bf16*)lds;
    LAS bf16* Gs = (LAS bf16*)(lds + 104448);
    LAS float* dts = (LAS float*)(lds + 139264);
    LAS float* acss = dts + 512;
    LAS float* wls = acss + 512;
    const int fr = lane & 15, fq = lane >> 4;
    {
        const int half = tid >> 8, cc = tid & 255; const bool isC = cc >= 128; const int n = cc & 127;
        const int ch = (isC ? 1536 : 1024) + g * 128 + n;
        const float w0 = conv_w[ch], w1 = conv_w[DCONV + ch], w2 = conv_w[2 * DCONV + ch], w3 = conv_w[3 * DCONV + ch], cb = conv_b[ch];
        const int l0 = half * 64;
        const bf16* src = P + (size_t)t0 * PCOLS + 1024 + ch;
        float r0, r1, r2;
        { const int s = c * CHUNK + l0;
          r0 = (s - 3 >= 0) ? bf2f(src[(ptrdiff_t)(l0 - 3) * PCOLS]) : 0.f; r1 = (s - 2 >= 0) ? bf2f(src[(ptrdiff_t)(l0 - 2) * PCOLS]) : 0.f; r2 = (s - 1 >= 0) ? bf2f(src[(ptrdiff_t)(l0 - 1) * PCOLS]) : 0.f; }
        bf16* cmg = (bf16*)(ws + WS_CMG);
#pragma unroll 1
        for (int o = 0; o < 8; ++o) {
            float raw[8], ov[8];
#pragma unroll
            for (int i = 0; i < 8; ++i) raw[i] = bf2f(src[(size_t)(l0 + o * 8 + i) * PCOLS]);
#pragma unroll
            for (int i = 0; i < 8; ++i) { const float v = w0 * r0 + w1 * r1 + w2 * r2 + w3 * raw[i] + cb; ov[i] = siluf(v); r0 = r1; r1 = r2; r2 = raw[i]; }
            unsigned pk[4];
#pragma unroll
            for (int i = 0; i < 4; ++i) pk[i] = pk2(ov[2 * i], ov[2 * i + 1]);
            const int l = l0 + o * 8;
            if (!isC) {
                *(LAS u32x4*)(BmT + n * LD1 + l) = (u32x4){pk[0], pk[1], pk[2], pk[3]};
#pragma unroll
                for (int i = 0; i < 8; ++i) Bm[(l + i) * LD1 + n] = (bf16)((i & 1) ? (pk[i >> 1] >> 16) : (pk[i >> 1] & 0xffffu));
            } else {
#pragma unroll
                for (int i = 0; i < 8; ++i) { const bf16 hv = (bf16)((i & 1) ? (pk[i >> 1] >> 16) : (pk[i >> 1] & 0xffffu)); Cm[(l + i) * LD1 + n] = hv; cmg[(size_t)(t0 + l + i) * 512 + g * 128 + n] = hv; }
            }
        }
    }
    if (wave < 4) {
        const int h = g * 4 + wave;
        const float* dtraw = (const float*)(ws + WS_DTRAW);
        const float bias = a.in[I_DT_BIAS][h], av = -__expf(a.in[I_A_LOG][h]);
        float d0 = dtraw[(size_t)(t0 + 2 * lane) * 16 + h] + bias, d1 = dtraw[(size_t)(t0 + 2 * lane + 1) * 16 + h] + bias;
        d0 = d0 > 20.f ? d0 : log1pf(__expf(d0)); d1 = d1 > 20.f ? d1 : log1pf(__expf(d1));
        const float v0 = d0 * av, v1 = d1 * av;
        float s = v0 + v1;
#pragma unroll
        for (int o = 1; o < 64; o <<= 1) { const float t = __shfl_up(s, o); if (lane >= o) s += t; }
        const float acs1 = s, acs0 = s - v1;
        const float last = __shfl(s, 63);
        dts[wave * 128 + 2 * lane] = d0; dts[wave * 128 + 2 * lane + 1] = d1;
        acss[wave * 128 + 2 * lane] = acs0; acss[wave * 128 + 2 * lane + 1] = acs1;
        wls[wave * 128 + 2 * lane] = __expf(last - acs0) * d0; wls[wave * 128 + 2 * lane + 1] = __expf(last - acs1) * d1;
        float* acsg = (float*)(ws + WS_ACS);
        acsg[(size_t)(t0 + 2 * lane) * 16 + h] = acs0; acsg[(size_t)(t0 + 2 * lane + 1) * 16 + h] = acs1;
        if (lane == 0) ((float*)(ws + WS_CDEC))[(b * NCH + c) * 16 + h] = __expf(last);
    }
    __syncthreads();
    f32x4 cbv[1][8];
#pragma unroll
    for (int n = 0; n < 8; ++n) cbv[0][n] = (f32x4){0.f, 0.f, 0.f, 0.f};
    wave_mma<1, 8>(cbv, Cm + wave * 16 * LD1, LD1, Bm, LD1, 128, lane);
    __syncthreads();
    {
        const int half = tid >> 8, cc = tid & 255;
        const int ch = g * 256 + cc;
        const float w0 = conv_w[ch], w1 = conv_w[DCONV + ch], w2 = conv_w[2 * DCONV + ch], w3 = conv_w[3 * DCONV + ch], cb = conv_b[ch];
        const int l0 = half * 64;
        const bf16* src = P + (size_t)t0 * PCOLS + 1024 + ch;
        float r0, r1, r2;
        { const int s = c * CHUNK + l0;
          r0 = (s - 3 >= 0) ? bf2f(src[(ptrdiff_t)(l0 - 3) * PCOLS]) : 0.f; r1 = (s - 2 >= 0) ? bf2f(src[(ptrdiff_t)(l0 - 2) * PCOLS]) : 0.f; r2 = (s - 1 >= 0) ? bf2f(src[(ptrdiff_t)(l0 - 1) * PCOLS]) : 0.f; }
        bf16* xs = (bf16*)(ws + WS_XS);
#pragma unroll 1
        for (int o = 0; o < 8; ++o) {
            float raw[8], ov[8];
#pragma unroll
            for (int i = 0; i < 8; ++i) raw[i] = bf2f(src[(size_t)(l0 + o * 8 + i) * PCOLS]);
#pragma unroll
            for (int i = 0; i < 8; ++i) { const float v = w0 * r0 + w1 * r1 + w2 * r2 + w3 * raw[i] + cb; ov[i] = siluf(v); r0 = r1; r1 = r2; r2 = raw[i]; }
            unsigned pk[4];
#pragma unroll
            for (int i = 0; i < 4; ++i) pk[i] = pk2(ov[2 * i], ov[2 * i + 1]);
            const int l = l0 + o * 8;
            *(LAS u32x4*)(XT + cc * LD1 + l) = (u32x4){pk[0], pk[1], pk[2], pk[3]};
#pragma unroll
            for (int i = 0; i < 8; ++i) xs[(size_t)(t0 + l + i) * 1024 + ch] = (bf16)((i & 1) ? (pk[i >> 1] >> 16) : (pk[i >> 1] & 0xffffu));
        }
    }
    __syncthreads();
    const int lrow = wave * 16 + fr;
#pragma unroll 1
    for (int r = 0; r < 4; ++r) {
        const int h = g * 4 + r;
        const float al = acss[r * 128 + lrow];
        LAS bf16* grow = Gs + lrow * LD1;
#pragma unroll
        for (int n = 0; n < 8; ++n) {
            const int s0 = n * 16 + 4 * fq;
            const f32x4 as = *(const LAS f32x4*)(acss + r * 128 + s0), ds = *(const LAS f32x4*)(dts + r * 128 + s0);
            float gv[4];
#pragma unroll
            for (int j = 0; j < 4; ++j) { const float df = fminf(al - as[j], 0.f); gv[j] = (s0 + j <= lrow) ? cbv[0][n][j] * __expf(df) * ds[j] : 0.f; }
            *(LAS u32x2*)(grow + s0) = (u32x2){pk2(gv[0], gv[1]), pk2(gv[2], gv[3])};
        }
        LDS_WAIT(); __builtin_amdgcn_wave_barrier();
        f32x4 yd[1][4];
#pragma unroll
        for (int n = 0; n < 4; ++n) yd[0][n] = (f32x4){0.f, 0.f, 0.f, 0.f};
        wave_mma<1, 4>(yd, Gs + wave * 16 * LD1, LD1, XT + r * 64 * LD1, LD1, 128, lane);
        bf16* ydg = (bf16*)(ws + WS_YDIAG) + (size_t)(t0 + lrow) * 1024 + h * 64;
#pragma unroll
        for (int n = 0; n < 4; ++n) *(u32x2*)(ydg + n * 16 + 4 * fq) = (u32x2){pk2(yd[0][n][0], yd[0][n][1]), pk2(yd[0][n][2], yd[0][n][3])};
        f32x4 st[4];
#pragma unroll
        for (int n = 0; n < 4; ++n) st[n] = (f32x4){0.f, 0.f, 0.f, 0.f};
        const LAS bf16* xa = XT + (r * 64 + (wave & 3) * 16 + fr) * LD1;
        const LAS bf16* bt = BmT + ((wave >> 2) * 64 + fr) * LD1;
#pragma unroll
        for (int k0 = 0; k0 < 128; k0 += 32) {
            const u32x4 xr = *(const LAS u32x4*)(xa + k0 + fq * 8);
            const f32x4 wa = *(const LAS f32x4*)(wls + r * 128 + k0 + fq * 8), wb = *(const LAS f32x4*)(wls + r * 128 + k0 + fq * 8 + 4);
            u32x4 xsq; xsq.x = pk2(bflo(xr.x) * wa[0], bfhi(xr.x) * wa[1]); xsq.y = pk2(bflo(xr.y) * wa[2], bfhi(xr.y) * wa[3]);
            xsq.z = pk2(bflo(xr.z) * wb[0], bfhi(xr.z) * wb[1]); xsq.w = pk2(bflo(xr.w) * wb[2], bfhi(xr.w) * wb[3]);
            const bf16x8 af = __builtin_bit_cast(bf16x8, xsq);
#pragma unroll
            for (int n = 0; n < 4; ++n) { const bf16x8 bfv = *(const LAS bf16x8*)(bt + n * 16 * LD1 + k0 + fq * 8); st[n] = __builtin_amdgcn_mfma_f32_16x16x32_bf16(bfv, af, st[n], 0, 0, 0); }
        }
        bf16* sg = (bf16*)(ws + WS_STATES) + ((size_t)((b * NCH + c) * 16 + h)) * 8192 + ((wave & 3) * 16 + fr) * 128 + (wave >> 2) * 64;
#pragma unroll
        for (int n = 0; n < 4; ++n) *(u32x2*)(sg + n * 16 + 4 * fq) = (u32x2){pk2(st[n][0], st[n][1]), pk2(st[n][2], st[n][3])};
        __builtin_amdgcn_wave_barrier();
    }
    __syncthreads();
}

constexpr int LD2 = 264;
__device__ __forceinline__ void pool_unit(const Args& a, LAS unsigned char* lds, int unit, int tid, int lane, int wave) {
    unsigned char* ws = a.ws;
    const int g = unit & 3, tt = unit >> 2;
    const int t0 = tt * 128, s0 = t0 & (SEQ - 1);
    const int w = 2 << g;
    const bf16* P = (const bf16*)(ws + WS_P);
    LAS bf16* U = (LAS bf16*)lds;
    LAS bf16* Ap = (LAS bf16*)(lds + 75504);
    LAS bf16* Bt = (LAS bf16*)lds;
    for (int i = tid; i < 143 * 32; i += NTHREADS) { const int r = i >> 5, cv = i & 31; const int s = s0 - 15 + r;
        u32x4 v = (u32x4){0u, 0u, 0u, 0u};
        if (s >= 0) v = *(const u32x4*)(P + (size_t)(t0 - 15 + r) * PCOLS + 3072 + g * 256 + cv * 8);
        *(LAS u32x4*)(U + r * LD2 + cv * 8) = v; }
    __syncthreads();
    {
        const int cc = tid & 255, l0 = (tid >> 8) * 64;
        float sum = 0.f;
        for (int j = 1; j < w; ++j) sum += bf2f(U[(15 + l0 - j) * LD2 + cc]);
        for (int l = l0; l < l0 + 64; ++l) {
            const float ucur = bf2f(U[(15 + l) * LD2 + cc]);
            sum += ucur;
            const int s = s0 + l; const float cntw = (float)((s + 1 < w) ? s + 1 : w);
            Ap[l * LD2 + cc] = (bf16)f2bf(sum / cntw - ucur);
            sum -= bf2f(U[(15 + l - w + 1) * LD2 + cc]);
        }
    }
    __syncthreads();
    const bf16* pw = (const bf16*)(ws + WS_PW) + (size_t)g * 256 * 256;
    const float* pscale = a.in[I_POOL_SCALE];
    bf16* ycat = (bf16*)(ws + WS_YCAT);
    const int fr = lane & 15, fq = lane >> 4;
#pragma unroll 1
    for (int hf = 0; hf < 2; ++hf) {
        tile_g2l(Bt, LD2, pw + (size_t)hf * 128 * 256, 256, 128, 256, tid);
        __syncthreads();
        f32x4 acc[1][8];
#pragma unroll
        for (int n = 0; n < 8; ++n) acc[0][n] = (f32x4){0.f, 0.f, 0.f, 0.f};
        wave_mma<1, 8>(acc, Ap + wave * 16 * LD2, LD2, Bt, LD2, 256, lane);
        bf16* orow = ycat + (size_t)(t0 + wave * 16 + fr) * 2048 + 1024 + g * 256 + hf * 128;
#pragma unroll
        for (int n = 0; n < 8; ++n) { const int d = n * 16 + 4 * fq; const f32x4 sc = *(const f32x4*)(pscale + g * 256 + hf * 128 + d); const f32x4 v = acc[0][n] * sc;
            *(u32x2*)(orow + d) = (u32x2){pk2(v[0], v[1]), pk2(v[2], v[3])}; }
        __syncthreads();
    }
}

__device__ __forceinline__ void ssd_combine_unit(const Args& a, LAS unsigned char* lds, int unit, int tid, int lane, int wave) {
    unsigned char* ws = a.ws;
    const int g = unit & 3, c = (unit >> 2) & 31, b = unit >> 7;
    const int t0 = b * SEQ + c * CHUNK;
    LAS bf16* Cm = (LAS bf16*)lds;
    LAS bf16* Pv = (LAS bf16*)(lds + 34816);
    tile_g2l(Cm, LD1, (const bf16*)(ws + WS_CMG) + (size_t)t0 * 512 + g * 128, 512, 128, 128, tid);
    tile_g2l(Pv, LD1, (const bf16*)(ws + WS_PREV) + ((size_t)((b * NCH + c) * 16 + g * 4)) * 8192, 128, 256, 128, tid);
    __syncthreads();
    const int fr = lane & 15, fq = lane >> 4;
    const int t = t0 + wave * 16 + fr;
    const bf16* P = (const bf16*)(ws + WS_P);
    const bf16* ydg = (const bf16*)(ws + WS_YDIAG) + (size_t)t * 1024;
    const bf16* xs = (const bf16*)(ws + WS_XS) + (size_t)t * 1024;
    const float* acsg = (const float*)(ws + WS_ACS) + (size_t)t * 16;
    f32x4 y[4][4]; float ss = 0.f;
#pragma unroll
    for (int r = 0; r < 4; ++r) {
        const int h = g * 4 + r;
        f32x4 yo[1][4];
#pragma unroll
        for (int n = 0; n < 4; ++n) yo[0][n] = (f32x4){0.f, 0.f, 0.f, 0.f};
        wave_mma<1, 4>(yo, Cm + wave * 16 * LD1, LD1, Pv + r * 64 * LD1, LD1, 128, lane);
        const float ea = __expf(acsg[h]), dsk = a.in[I_D_SKIP][h];
#pragma unroll
        for (int n = 0; n < 4; ++n) {
            const int col = h * 64 + n * 16 + 4 * fq;
            const u32x2 ydv = *(const u32x2*)(ydg + col); const f32x4 yd = (f32x4){bflo(ydv.x), bfhi(ydv.x), bflo(ydv.y), bfhi(ydv.y)};
            const u32x2 xv = *(const u32x2*)(xs + col), zv = *(const u32x2*)(P + (size_t)t * PCOLS + col);
            const float xf[4] = {bflo(xv.x), bfhi(xv.x), bflo(xv.y), bfhi(xv.y)}, zf[4] = {bflo(zv.x), bfhi(zv.x), bflo(zv.y), bfhi(zv.y)};
#pragma unroll
            for (int j = 0; j < 4; ++j) { const float v = (yd[j] + yo[0][n][j] * ea + dsk * xf[j]) * siluf(zf[j]); y[r][n][j] = v; ss += v * v; }
        }
    }
    ss += __shfl_xor(ss, 16); ss += __shfl_xor(ss, 32);
    const float rstd = rsqrtf(ss * (1.f / 256.f) + EPS);
    const float* nw = a.in[I_SSD_NORM] + g * 256;
    bf16* orow = (bf16*)(ws + WS_YCAT) + (size_t)t * 2048 + g * 256;
#pragma unroll
    for (int r = 0; r < 4; ++r)
#pragma unroll
        for (int n = 0; n < 4; ++n) { const int col = r * 64 + n * 16 + 4 * fq; const f32x4 w4 = *(const f32x4*)(nw + col); const f32x4 v = y[r][n] * rstd * w4;
            *(u32x2*)(orow + col) = (u32x2){pk2(v[0], v[1]), pk2(v[2], v[3])}; }
    __syncthreads();
}

__device__ __forceinline__ void attn_unit(const Args& a, LAS unsigned char* lds, int unit, int tid, int lane, int wave) {
    unsigned char* ws = a.ws;
    const int h = unit & 3, qt = (unit >> 2) & 31, b = unit >> 7;
    const int t0 = b * SEQ + qt * 128;
    const bf16* q = (const bf16*)(ws + WS_Q); const bf16* km = (const bf16*)(ws + WS_KMEM); const bf16* vt = (const bf16*)(ws + WS_VT);
    LAS bf16* Qc = (LAS bf16*)lds;
    LAS bf16* Kc = (LAS bf16*)(lds + 34816);
    LAS bf16* Ps = (LAS bf16*)lds;
    LAS bf16* Vc = (LAS bf16*)(lds + 67584);
    const int fr = lane & 15, fq = lane >> 4;
    f32x4 s[1][16];
#pragma unroll
    for (int n = 0; n < 16; ++n) s[0][n] = (f32x4){0.f, 0.f, 0.f, 0.f};
#pragma unroll 1
    for (int dc = 0; dc < 4; ++dc) {
        tile_g2l(Qc, LD1, q + (size_t)t0 * 2048 + h * 512 + dc * 128, 2048, 128, 128, tid);
        tile_g2l(Kc, LD1, km + (size_t)(b * NMEM) * 2048 + h * 512 + dc * 128, 2048, 256, 128, tid);
        __syncthreads();
        wave_mma<1, 16>(s, Qc + wave * 16 * LD1, LD1, Kc, LD1, 128, lane);
        __syncthreads();
    }
    float mx = -3.0e38f;
#pragma unroll
    for (int n = 0; n < 16; ++n)
#pragma unroll
        for (int j = 0; j < 4; ++j) mx = fmaxf(mx, s[0][n][j]);
    mx = fmaxf(mx, __shfl_xor(mx, 16)); mx = fmaxf(mx, __shfl_xor(mx, 32));
    float sum = 0.f;
#pragma unroll
    for (int n = 0; n < 16; ++n)
#pragma unroll
        for (int j = 0; j < 4; ++j) { const float e = __expf(s[0][n][j] - mx); s[0][n][j] = e; sum += e; }
    sum += __shfl_xor(sum, 16); sum += __shfl_xor(sum, 32);
    const float inv = 1.0f / sum;
    LAS bf16* prow = Ps + (wave * 16 + fr) * LD2;
#pragma unroll
    for (int n = 0; n < 16; ++n) { const f32x4 p = s[0][n] * inv; *(LAS u32x2*)(prow + n * 16 + 4 * fq) = (u32x2){pk2(p[0], p[1]), pk2(p[2], p[3])}; }
    bf16* orow = (bf16*)(ws + WS_O) + (size_t)(t0 + wave * 16 + fr) * 2048 + h * 512;
#pragma unroll 1
    for (int dc = 0; dc < 4; ++dc) {
        tile_g2l(Vc, LD2, vt + (size_t)(h * 512 + dc * 128) * 512 + b * NMEM, 512, 128, 256, tid);
        __syncthreads();
        f32x4 o[1][8];
#pragma unroll
        for (int n = 0; n < 8; ++n) o[0][n] = (f32x4){0.f, 0.f, 0.f, 0.f};
        wave_mma<1, 8>(o, Ps + wave * 16 * LD2, LD2, Vc, LD2, 256, lane);
#pragma unroll
        for (int n = 0; n < 8; ++n) *(u32x2*)(orow + dc * 128 + n * 16 + 4 * fq) = (u32x2){pk2(o[0][n][0], o[0][n][1]), pk2(o[0][n][2], o[0][n][3])};
        __syncthreads();
    }
}

__device__ __forceinline__ void router_phase(const Args& a, LAS unsigned char* lds, int tid, int lane, int wave, int vcu, int G) {
    unsigned char* ws = a.ws;
    LAS bf16* wr = (LAS bf16*)lds;
    LAS int* pick_e = (LAS int*)(lds + 131072);
    LAS float* pick_g = (LAS float*)(lds + 131072 + 512);
    LAS int* pick_lp = (LAS int*)(lds + 131072 + 1024);
    LAS int* lcnt = (LAS int*)(lds + 131072 + 1536);
    LAS int* lbase = lcnt + 32;
    { const u32x4* src = (const u32x4*)(ws + WS_WR); for (int i = tid; i < 32 * 2048 / 8; i += NTHREADS) ((LAS u32x4*)wr)[i] = src[i]; }
    const bf16* h2 = (const bf16*)(ws + WS_H2); const float* nw = a.in[I_NORM_FFN]; const float* brt = a.in[I_B_ROUTER];
    bf16* hn = (bf16*)(ws + WS_HN);
    unsigned* ctl = (unsigned*)(ws + WS_CTL);
    int* tok_of = (int*)(ws + WS_TOK); int* rec_e = (int*)(ws + WS_REC); int* rec_p = rec_e + T * 4; float* rec_g = (float*)(rec_p + T * 4);
    for (int base = vcu * 32; base < T; base += G * 32) {
        if (tid < 32) lcnt[tid] = 0;
        __syncthreads();
#pragma unroll 1
        for (int i = 0; i < 4; ++i) {
            const int lr = wave * 4 + i, m = base + lr;
            const bf16* xr = h2 + (size_t)m * D;
            f32x4 v[8]; float ss = 0.f;
#pragma unroll
            for (int j = 0; j < 8; ++j) { v[j] = ld_row4(xr, lane, j); ss += (v[j].x * v[j].x + v[j].y * v[j].y) + (v[j].z * v[j].z + v[j].w * v[j].w); }
            const float rstd = rsqrtf(wave_sum(ss) * (1.f / D) + EPS);
            unsigned* o4 = (unsigned*)((unsigned char*)hn + (size_t)m * D) + lane;
#pragma unroll
            for (int j = 0; j < 8; ++j) { const f32x4 w4 = ((const f32x4*)nw)[lane + 64 * j]; v[j] = v[j] * rstd * w4; o4[64 * j] = pk4_fp8(v[j].x, v[j].y, v[j].z, v[j].w); }
            float pe[NE];
#pragma unroll
            for (int e = 0; e < NE; ++e) {
                const LAS u32x2* wrow = (const LAS u32x2*)(wr + e * 2048) + lane; float p = 0.f;
#pragma unroll
                for (int j = 0; j < 8; ++j) { const u32x2 w2 = wrow[64 * j]; p += (v[j].x * bflo(w2.x) + v[j].y * bfhi(w2.x)) + (v[j].z * bflo(w2.y) + v[j].w * bfhi(w2.y)); }
                pe[e] = p;
            }
            float w16[16], w8[8], w4[4], w2r[2], w1;
            { const bool bb = (lane & 32) != 0;
#pragma unroll
              for (int i = 0; i < 16; ++i) { const float keep = bb ? pe[16 + i] : pe[i], send = bb ? pe[i] : pe[16 + i]; w16[i] = keep + __shfl_xor(send, 32); } }
            { const bool bb = (lane & 16) != 0;
#pragma unroll
              for (int i = 0; i < 8; ++i) { const float keep = bb ? w16[8 + i] : w16[i], send = bb ? w16[i] : w16[8 + i]; w8[i] = keep + __shfl_xor(send, 16); } }
            { const bool bb = (lane & 8) != 0;
#pragma unroll
              for (int i = 0; i < 4; ++i) { const float keep = bb ? w8[4 + i] : w8[i], send = bb ? w8[i] : w8[4 + i]; w4[i] = keep + __shfl_xor(send, 8); } }
            { const bool bb = (lane & 4) != 0;
#pragma unroll
              for (int i = 0; i < 2; ++i) { const float keep = bb ? w4[2 + i] : w4[i], send = bb ? w4[i] : w4[2 + i]; w2r[i] = keep + __shfl_xor(send, 4); } }
            { const bool bb = (lane & 2) != 0; const float keep = bb ? w2r[1] : w2r[0], send = bb ? w2r[0] : w2r[1]; w1 = keep + __shfl_xor(send, 2); }
            w1 += __shfl_xor(w1, 1);
            const int myexp = lane >> 1;
            float lg = (lane & 1) ? -3.0e38f : w1 + brt[myexp];
            float tv[4]; int ti[4];
#pragma unroll
            for (int k = 0; k < 4; ++k) {
                float bv = lg; int bi = myexp;
#pragma unroll
                for (int o = 1; o < 64; o <<= 1) { const float ov = __shfl_xor(bv, o); const int oi = __shfl_xor(bi, o); if (ov > bv || (ov == bv && oi < bi)) { bv = ov; bi = oi; } }
                tv[k] = bv; ti[k] = bi; if (myexp == bi) lg = -3.0e38f;
            }
            const float e1 = __expf(tv[1] - tv[0]), e2 = __expf(tv[2] - tv[0]), e3 = __expf(tv[3] - tv[0]); const float inv = 1.0f / (1.0f + e1 + e2 + e3);
            if (lane < 4) { const int ee = lane == 0 ? ti[0] : lane == 1 ? ti[1] : lane == 2 ? ti[2] : ti[3]; const float gg = (lane == 0 ? 1.0f : lane == 1 ? e1 : lane == 2 ? e2 : e3) * inv;
                pick_e[lr * 4 + lane] = ee; pick_g[lr * 4 + lane] = gg; }
        }
        __syncthreads();
        if (tid < 128) pick_lp[tid] = atomicAdd((int*)&lcnt[pick_e[tid]], 1);
        __syncthreads();
        if (tid < 32) { const int n = lcnt[tid]; lbase[tid] = n ? (int)__hip_atomic_fetch_add(ctl + CW_CNT + 64 * tid, (unsigned)n, __ATOMIC_RELAXED, __HIP_MEMORY_SCOPE_AGENT) : 0; }
        __syncthreads();
        if (tid < 128) { const int e = pick_e[tid], pos = lbase[e] + pick_lp[tid], m = base + (tid >> 2);
            tok_of[e * 8192 + pos] = m; rec_e[m * 4 + (tid & 3)] = e; rec_p[m * 4 + (tid & 3)] = pos; rec_g[m * 4 + (tid & 3)] = pick_g[tid]; }
        __syncthreads();
    }
}

__device__ __forceinline__ void moe_tile_starts(const unsigned* ctl, LAS int* ts, int tid) {
    if (tid < 64) {
        const int c = (tid < NE) ? (int)__hip_atomic_load(ctl + CW_CNT + 64 * tid, __ATOMIC_RELAXED, __HIP_MEMORY_SCOPE_AGENT) : 0;
        const int nt = (c + 255) >> 8; int s = nt;
#pragma unroll
        for (int o = 1; o < 64; o <<= 1) { const int t = __shfl_up(s, o); if (tid >= o) s += t; }
        if (tid < NE) ts[tid] = s - nt;
        if (tid == NE - 1) ts[NE] = s;
    }
    __syncthreads();
}


__device__ __forceinline__ void final_phase(const Args& a, LAS unsigned char* lds, int tid, int lane, int wave, int vcu, int G) {
    unsigned char* ws = a.ws;
    LAS int* ts = (LAS int*)lds;
    moe_tile_starts((const unsigned*)(ws + WS_CTL), ts, tid);
#ifndef FINAL_MODE
#define FINAL_MODE 0
#endif
    const bf16* h2 = (const bf16*)(ws + WS_H2); const float* nw = a.in[I_NORM_FINAL]; const bf16* y = (const bf16*)(ws + WS_Y);
    const int* rec_e = (const int*)(ws + WS_REC); const int* rec_p = rec_e + T * 4; const float* rec_g = (const float*)(rec_p + T * 4);
    const float* bd = a.in[I_B_DOWN];
    const int gw = vcu * NWAVES + wave, NGW = G * NWAVES;
    f32x4 wv[8];
#pragma unroll
    for (int j = 0; j < 8; ++j) wv[j] = ((const f32x4*)nw)[lane + 64 * j];
    for (int m = gw; m < T; m += NGW) {
        const bf16* xr = h2 + (size_t)m * D;
        f32x4 v[8];
#pragma unroll
        for (int j = 0; j < 8; ++j) v[j] = ld_row4(xr, lane, j);
#pragma unroll 1
        for (int k = 0; k < (FINAL_MODE ? 0 : 4); ++k) {
            const int e = rec_e[m * 4 + k], pos = rec_p[m * 4 + k]; const float gt = rec_g[m * 4 + k];
            const int slot = ts[e] * 256 + pos;
            const u32x2* yr = (const u32x2*)(y + (size_t)slot * 2048) + lane;
#pragma unroll
            for (int j = 0; j < 8; ++j) { const u32x2 w2 = __builtin_nontemporal_load(&yr[64 * j]); v[j].x += gt * bflo(w2.x); v[j].y += gt * bfhi(w2.x); v[j].z += gt * bflo(w2.y); v[j].w += gt * bfhi(w2.y); }
        }
        float ss = 0.f;
#pragma unroll
        for (int j = 0; j < 8; ++j) ss += (v[j].x * v[j].x + v[j].y * v[j].y) + (v[j].z * v[j].z + v[j].w * v[j].w);
        const float rstd = rsqrtf(wave_sum(ss) * (1.f / D) + EPS);
        f32x4* o = (f32x4*)(a.out + (size_t)m * D) + lane;
#pragma unroll
        for (int j = 0; j < 8; ++j) { f32x4 r = v[j] * rstd * wv[j];
#ifdef SANITIZE
            for (int q = 0; q < 4; ++q) if (!(fabsf(r[q]) < 1e30f)) r[q] = 0.f;
#endif
            __builtin_nontemporal_store(r, &o[64 * j]); }
    }
    (void)bd;
}

__global__ void __launch_bounds__(NTHREADS, 2) hybrid_fwd(Args args) {
    extern __shared__ __attribute__((aligned(16))) unsigned char lds_raw[];
    LAS unsigned char* lds = (LAS unsigned char*)lds_raw;
    volatile LAS unsigned* MISC = (volatile LAS unsigned*)(lds + MISC_OFF);
    const int tid = threadIdx.x, lane = tid & 63, wave = __builtin_amdgcn_readfirstlane(tid >> 6);
    const int G = gridDim.x; const int bx = blockIdx.x; const int vcu = (G % 8 == 0) ? (bx % 8) * (G / 8) + bx / 8 : bx;
    unsigned char* ws = args.ws;
    unsigned* ctl = (unsigned*)(ws + WS_CTL);
    for (int u = tid; u < (LDS_BYTES - MISC_OFF) / 4; u += NTHREADS) ((LAS unsigned*)(lds + MISC_OFF))[u] = 0u;
    __syncthreads();
    XcdBarrier bar; bar.bar = ctl + CW_BAR; bar.x = 0; bar.st = nullptr;
    if (MK_LAUNCHES == 1) bar = xcd_barrier_post(ctl + CW_BAR, MISC + 8);
    const int lo = args.ph_lo, hi = args.ph_hi;
#ifndef PHASE_MASK
#define PHASE_MASK 0x3fff
#endif
#define IN(k) ((((PHASE_MASK) >> (k)) & 1) && lo <= (k) && (k) < hi)
#define SEAM(k) do { if (IN(k) && IN((k) + 1)) xcd_barrier(bar); } while (0)
#define REP_BEGIN(k) {
#define REP_END(k) }

    if (IN(0)) { REP_BEGIN(0) p0_prologue(args, lds, tid, lane, wave, vcu, G); REP_END(0) SEAM(0); }

    if (IN(1)) {
        P1Sched S; S.G = G; S.c = bx;
        S.inproj = DenseSched{(const char*)(ws + WS_HN), (const char*)(ws + WS_WIN), (char*)(ws + WS_P), PCOLS, 32, 16, 512, G, bx};
        S.memn = (const char*)(ws + WS_MEMN); S.wk = (const char*)(ws + WS_WK); S.wv = (const char*)(ws + WS_WV); S.kmem = (char*)(ws + WS_KMEM); S.vt = (char*)(ws + WS_VT);
        pg8::EpiBf16P<0> E;
        pg8::gemm_phase<pg8::EpiBf16P<0>, P1Sched, false>(lds, S, E);
        SEAM(1);
    }
    if (IN(2)) {
        REP_BEGIN(2)
        for (int u = vcu; u < 256; u += G) ssd_chunk_unit(args, lds, u, tid, lane, wave);
        for (int u = vcu; u < 256; u += G) pool_unit(args, lds, u, tid, lane, wave);
        REP_END(2)
        SEAM(2);
    }
    if (IN(3)) {
        REP_BEGIN(3)
        const bf16* st = (const bf16*)(ws + WS_STATES); const float* cdec = (const float*)(ws + WS_CDEC); bf16* prev = (bf16*)(ws + WS_PREV);
        for (int idx = bx * NTHREADS + tid; idx < NB * 16 * 4096; idx += G * NTHREADS) {
            const int b = idx >> 16, rem = idx & 65535, h = rem >> 12, e2 = rem & 4095;
            float h0 = 0.f, h1 = 0.f;
#pragma unroll 4
            for (int c = 0; c < NCH; ++c) {
                const size_t o = ((size_t)((b * NCH + c) * 16 + h)) * 8192 + e2 * 2;
                const unsigned sw = *(const unsigned*)(st + o); const f32x2 s = (f32x2){bflo(sw), bfhi(sw)}; const float dc = cdec[(b * NCH + c) * 16 + h];
                *(unsigned*)(prev + o) = pk2(h0, h1);
                h0 = h0 * dc + s.x; h1 = h1 * dc + s.y;
            }
        }
        REP_END(3)
        SEAM(3);
    }
    if (IN(4)) { REP_BEGIN(4) for (int u = vcu; u < 256; u += G) ssd_combine_unit(args, lds, u, tid, lane, wave); REP_END(4) SEAM(4); }
    if (IN(5)) {
        DenseSched S{(const char*)(ws + WS_YCAT), (const char*)(ws + WS_WOUT), nullptr, 2048, 32, 8, 256, G, bx};
        pg8::EpiResBf16<true> E{(const void*)args.in[I_X], (bf16*)(ws + WS_H1), 2048};
        pg8::gemm_phase<pg8::EpiResBf16<true>, DenseSched, false>(lds, S, E);
        SEAM(5);
    }
    if (IN(6)) { rms_rows_bf16((const bf16*)(ws + WS_H1), args.in[I_NORM_XATTN], (bf16*)(ws + WS_HN), T, vcu * NWAVES + wave, G * NWAVES, lane); SEAM(6); }
    if (IN(7)) {
        DenseSched S{(const char*)(ws + WS_HN), (const char*)(ws + WS_WQ), (char*)(ws + WS_Q), 2048, 32, 8, 256, G, bx};
        pg8::EpiBf16P<1> E;
        pg8::gemm_phase<pg8::EpiBf16P<1>, DenseSched, false>(lds, S, E);
        SEAM(7);
    }
    if (IN(8)) { REP_BEGIN(8) for (int u = vcu; u < 256; u += G) attn_unit(args, lds, u, tid, lane, wave); REP_END(8) SEAM(8); }
    if (IN(9)) {
        DenseSched S{(const char*)(ws + WS_O), (const char*)(ws + WS_WO), nullptr, 2048, 32, 8, 256, G, bx};
        pg8::EpiResBf16<false> E{(const void*)(ws + WS_H1), (bf16*)(ws + WS_H2), 2048};
        pg8::gemm_phase<pg8::EpiResBf16<false>, DenseSched, false>(lds, S, E);
        SEAM(9);
    }
    if (IN(10)) { router_phase(args, lds, tid, lane, wave, vcu, G); SEAM(10); }
    if (IN(11)) {
        REP_BEGIN(11)
        LAS int* ts = (LAS int*)(lds + 131072);
        moe_tile_starts(ctl, ts, tid);
        LAS int* tokl = (LAS int*)(lds + 131072 + 256);
        MoeSched S{ts, (const int*)(ctl + CW_CNT), (const int*)(ws + WS_TOK), (const char*)(ws + WS_HN), (const char*)(ws + WS_WGU), (char*)(ws + WS_ACT), 16, 128, G, bx, (size_t)4096 * 2048, true, nullptr, tokl};
        for (int i = 0; i < 15; ++i) { pg8::Unit u; if (!S.next(i, u)) break; if (tid < 256) tokl[i * 256 + tid] = (tid < u.cnt) ? u.tok[tid] : 0; }
        __syncthreads();
        pg8::EpiSwiglu E{args.in[I_B_GATE], args.in[I_B_UP]};
        pg8::gemm_phase<pg8::EpiSwiglu, MoeSched, true, true>(lds, S, E);
        REP_END(11)
        SEAM(11);
    }
    if (IN(12)) {
        REP_BEGIN(12)
        LAS int* ts = (LAS int*)(lds + 131072);
        moe_tile_starts(ctl, ts, tid);
        MoeSched S{ts, (const int*)(ctl + CW_CNT), (const int*)(ws + WS_TOK), (const char*)(ws + WS_ACT), (const char*)(ws + WS_WD), (char*)(ws + WS_Y), 8, 256, G, bx, (size_t)2048 * 2048, false, nullptr, nullptr};
        pg8::EpiBf16B E{args.in[I_B_DOWN], 2048};
        pg8::gemm_phase<pg8::EpiBf16B, MoeSched, false, true>(lds, S, E);
        REP_END(12)
        SEAM(12);
    }
#ifdef DIAG
    if (lo <= 13 && 13 < hi) {
        unsigned flags = 0;
        const size_t gt = (size_t)bx * NTHREADS + tid, gn = (size_t)G * NTHREADS;
    }
    if (lo <= 14 && 14 < hi) {
        for (size_t i = (size_t)bx * NTHREADS + tid; i < (size_t)T * D; i += (size_t)G * NTHREADS) args.out[i] = 0.f;
        if (bx == 0 && tid == 0) args.out[0] = 1000.0f * (float)ctl[10];
    }
#else
    if (IN(13)) { final_phase(args, lds, tid, lane, wave, vcu, G); }
#endif
#undef IN
#undef SEAM
}

extern "C" void kernel_launch(void* const* d_in, const int* in_sizes, int n_in, void* d_out, int out_size, void* d_ws, size_t ws_size, hipStream_t stream) {
    static int grid = 0;
    if (grid == 0) {
        if (n_in != 28 || out_size != T * D || ws_size < WS_END) { fprintf(stderr, "kernel_launch: unexpected shapes (n_in %d, out %d, ws %zu < %zu)\n", n_in, out_size, ws_size, (size_t)WS_END); grid = -1; return; }
        int dev = 0, cus = 0, per_cu = 0;
        if (hipGetDevice(&dev) != hipSuccess || hipDeviceGetAttribute(&cus, hipDeviceAttributeMultiprocessorCount, dev) != hipSuccess) { grid = -1; return; }
        if (hipFuncSetAttribute((const void*)hybrid_fwd, hipFuncAttributeMaxDynamicSharedMemorySize, LDS_BYTES) != hipSuccess) { fprintf(stderr, "kernel_launch: hipFuncSetAttribute failed\n"); grid = -1; return; }
        if (hipOccupancyMaxActiveBlocksPerMultiprocessor(&per_cu, (const void*)hybrid_fwd, NTHREADS, LDS_BYTES) != hipSuccess || per_cu < 1)
            fprintf(stderr, "kernel_launch: occupancy query reports %d workgroups per CU\n", per_cu);
        (void)hipGetLastError();
        grid = cus;
    }
    if (grid < 0) return;
    if (hipMemsetAsync((char*)d_ws + WS_CTL, 0, CTL_ZERO_BYTES, stream) != hipSuccess) return;
    Args a{};
    for (int i = 0; i < 28; ++i) a.in[i] = (const float*)d_in[i];
    a.out = (float*)d_out; a.ws = (unsigned char*)d_ws; a.pad = 0;
#ifndef DUP_MASK
#define DUP_MASK 0
#endif
    for (int li = 0; li < MK_LAUNCHES; ++li) for (int rep = 0; rep < 1 + ((MK_LAUNCHES > 1) ? ((DUP_MASK >> li) & 1) : 0); ++rep) {
        a.pad = rep;
        if (MK_LAUNCHES > 1 && li == 10) hipMemsetAsync((char*)d_ws + WS_CTL + (size_t)CW_CNT * 4, 0, 32 * 64 * 4, stream);
        a.ph_lo = (MK_LAUNCHES == 1) ? 0 : li; a.ph_hi = (MK_LAUNCHES == 1) ? NPHASE + 1 : li + 1; a.li = li;
        hipLaunchKernelGGL(hybrid_fwd, dim3(grid), dim3(NTHREADS), LDS_BYTES, stream, a);
        const hipError_t le = hipPeekAtLastError();
        if (le != hipSuccess) { fprintf(stderr, "kernel_launch: launch %d failed: %s\n", li, hipGetErrorName(le)); break; }
    }
}
```

```cpp
#include <hip/hip_runtime.h>
#include <cstdio>
#include <cstdint>

#ifndef MK_LAUNCHES
#define MK_LAUNCHES 1
#endif

#define GAS __attribute__((address_space(1)))
#define LAS __attribute__((address_space(3)))
typedef unsigned short bf16;
typedef short bf16x8 __attribute__((ext_vector_type(8)));
typedef float f32x4 __attribute__((ext_vector_type(4)));
typedef float f32x2 __attribute__((ext_vector_type(2)));
typedef unsigned u32x4 __attribute__((ext_vector_type(4)));
typedef unsigned u32x2 __attribute__((ext_vector_type(2)));
typedef int i32x8 __attribute__((ext_vector_type(8)));
typedef int i32x4 __attribute__((ext_vector_type(4)));

constexpr int NB = 2, SEQ = 4096, T = NB * SEQ, D = 2048;
constexpr int DSSD = 1024, HEADS = 16, HD = 64, GROUPS = 4, NST = 128, CHUNK = 128, NCH = SEQ / CHUNK;
constexpr int DIN = 4112, PCOLS = 4096;
constexpr int DCONV = 2048;
constexpr int NMEM = 256, XH = 4, XHD = 512;
constexpr int NE = 32, TOPK = 4;
constexpr int SLOT_CAP = 41216;
constexpr float EPS = 1e-5f;
constexpr int NTHREADS = 512, NWAVES = 8;
constexpr int NPHASE = 14;

constexpr size_t MiB = 1u << 20;
constexpr size_t WS_CTL = 0, CTL_ZERO_BYTES = 1 * MiB;
constexpr size_t WS_WIN = 1 * MiB;
constexpr size_t WS_WOUT = WS_WIN + 16 * MiB;
constexpr size_t WS_WQ = WS_WOUT + 8 * MiB;
constexpr size_t WS_WK = WS_WQ + 8 * MiB;
constexpr size_t WS_WV = WS_WK + 8 * MiB;
constexpr size_t WS_WO = WS_WV + 8 * MiB;
constexpr size_t WS_PW = WS_WO + 8 * MiB;
constexpr size_t WS_WR = WS_PW + 1 * MiB;
constexpr size_t WS_WGU = WS_WR + 1 * MiB;
constexpr size_t WS_WD = WS_WGU + 512 * MiB;
constexpr size_t WS_HN = WS_WD + 256 * MiB;
constexpr size_t WS_MEMN = WS_HN + 32 * MiB;
constexpr size_t WS_P = WS_MEMN + 2 * MiB;
constexpr size_t WS_DTRAW = WS_P + 64 * MiB;
constexpr size_t WS_ACS = WS_DTRAW + 1 * MiB;
constexpr size_t WS_CDEC = WS_ACS + 1 * MiB;
constexpr size_t WS_KMEM = WS_CDEC + 1 * MiB;
constexpr size_t WS_VT = WS_KMEM + 2 * MiB;
constexpr size_t WS_XS = WS_VT + 2 * MiB;
constexpr size_t WS_CMG = WS_XS + 16 * MiB;
constexpr size_t WS_YDIAG = WS_CMG + 8 * MiB;
constexpr size_t WS_STATES = WS_YDIAG + 32 * MiB;
constexpr size_t WS_PREV = WS_STATES + 32 * MiB;
constexpr size_t WS_YCAT = WS_PREV + 16 * MiB;
constexpr size_t WS_H1 = WS_YCAT + 32 * MiB;
constexpr size_t WS_H2 = WS_H1 + 64 * MiB;
constexpr size_t WS_Q = WS_H2 + 64 * MiB;
constexpr size_t WS_O = WS_Q + 32 * MiB;
constexpr size_t WS_TOK = WS_O + 32 * MiB;
constexpr size_t WS_REC = WS_TOK + 1 * MiB;
constexpr size_t WS_ACT = WS_REC + 1 * MiB;
constexpr size_t WS_Y = WS_ACT + 162 * MiB;
constexpr size_t WS_END = WS_Y + 162 * MiB;
static_assert((size_t)SLOT_CAP * 2048 * 2 <= 162 * MiB, "act");

constexpr int CW_BAR = 4096;
constexpr int CW_CNT = 16384;

constexpr int LDS_BYTES = 147456;
constexpr int MISC_OFF = 146944;

#define LDS_WAIT() asm volatile("s_waitcnt lgkmcnt(0)" ::: "memory")
#define VM_WAIT() asm volatile("s_waitcnt vmcnt(0)" ::: "memory")

__device__ __forceinline__ unsigned f2bf(float f) { unsigned u = __builtin_bit_cast(unsigned, f); return (u + 0x7fffu + ((u >> 16) & 1u)) >> 16; }
typedef __bf16 bf16x2_t __attribute__((ext_vector_type(2)));
__device__ __forceinline__ unsigned pk2(float lo, float hi) { const f32x2 v = {lo, hi}; const bf16x2_t b = __builtin_convertvector(v, bf16x2_t); return __builtin_bit_cast(unsigned, b); }
__device__ __forceinline__ unsigned pk4_fp8(float a, float b, float c, float d) { unsigned w = 0u; w = (unsigned)__builtin_amdgcn_cvt_pk_fp8_f32(a, b, (int)w, false); w = (unsigned)__builtin_amdgcn_cvt_pk_fp8_f32(c, d, (int)w, true); return w; }
__device__ __forceinline__ float bf2f(unsigned b) { return __builtin_bit_cast(float, b << 16); }
__device__ __forceinline__ float bflo(unsigned w) { return __builtin_bit_cast(float, w << 16); }
__device__ __forceinline__ float bfhi(unsigned w) { return __builtin_bit_cast(float, w & 0xffff0000u); }
__device__ __forceinline__ float wave_sum(float v) {
#pragma unroll
    for (int o = 1; o < 64; o <<= 1) v += __shfl_xor(v, o);
    return v;
}
__device__ __forceinline__ float siluf(float x) { return x / (1.0f + __expf(-x)); }

namespace pg8 {
constexpr int BM = 256, BK = 64, HALF = 128, HTB = HALF * BK * 2, STAGE_BYTES = 8 * HTB, KD = 2048;
__host__ __device__ __forceinline__ int lds_byte(int r, int c) { const int st = (r >> 4) * 2 + (c >> 5), rr = r & 15, cc = c & 31, ob = rr * 64 + cc * 2; return st * 1024 + (ob ^ (((ob >> 9) & 1) << 5)); }
__host__ __device__ __forceinline__ void stage_rc(int b, int& R, int& C) { const int st = b / 1024, sb = b % 1024, swz = sb ^ (((sb >> 9) & 1) << 5); R = (st >> 1) * 16 + swz / 64; C = (st & 1) * 32 + (swz % 64) / 2; }
__host__ __device__ __forceinline__ int perm32(int rho) { const int n = rho >> 4, i = rho & 15; return 8 * (i >> 2) + 4 * n + (i & 3); }

struct Unit { const char* A; const char* B; char* O; const int* tok; int ldc, row0, col0, e, cnt, ui; };

template <int SC> struct EpiBf16P {
    static constexpr bool PERM = true;
    __device__ __forceinline__ void operator()(const f32x4 (&acc)[2][2][4][2], const Unit& u, int wr, int wc, int fr, int fq) const {
        const float scale = SC ? 0.04419417382415922f : 1.0f;
        const int rowt = wr * 64 + fr, colt = wc * 32 + 8 * fq;
        bf16* base = (bf16*)u.O;
#pragma unroll
        for (int ai = 0; ai < 2; ++ai)
#pragma unroll
            for (int m = 0; m < 4; ++m) { bf16* rowp = base + (size_t)(u.row0 + rowt + ai * HALF + m * 16) * u.ldc + u.col0 + colt;
#pragma unroll
                for (int bj = 0; bj < 2; ++bj) { const f32x4 v0 = acc[ai][bj][m][0] * scale, v1 = acc[ai][bj][m][1] * scale;
                    u32x4 w; w.x = pk2(v0[0], v0[1]); w.y = pk2(v0[2], v0[3]); w.z = pk2(v1[0], v1[1]); w.w = pk2(v1[2], v1[3]);
                    *(u32x4*)(rowp + bj * HALF) = w; } }
    }
};
struct EpiBf16B {
    static constexpr bool PERM = true;
    const float* bias; int bias_stride;
    __device__ __forceinline__ void operator()(const f32x4 (&acc)[2][2][4][2], const Unit& u, int wr, int wc, int fr, int fq) const {
        const int rowt = wr * 64 + fr, colt = wc * 32 + 8 * fq;
        bf16* base = (bf16*)u.O;
        f32x4 bv[2][2];
#pragma unroll
        for (int bj = 0; bj < 2; ++bj)
#pragma unroll
            for (int n = 0; n < 2; ++n) bv[bj][n] = *(const f32x4*)(bias + (size_t)u.e * bias_stride + u.col0 + colt + bj * HALF + 4 * n);
#pragma unroll
        for (int ai = 0; ai < 2; ++ai)
#pragma unroll
            for (int m = 0; m < 4; ++m) { bf16* rowp = base + (size_t)(u.row0 + rowt + ai * HALF + m * 16) * u.ldc + u.col0 + colt;
#pragma unroll
                for (int bj = 0; bj < 2; ++bj) { const f32x4 v0 = acc[ai][bj][m][0] + bv[bj][0], v1 = acc[ai][bj][m][1] + bv[bj][1];
                    u32x4 w; w.x = pk2(v0[0], v0[1]); w.y = pk2(v0[2], v0[3]); w.z = pk2(v1[0], v1[1]); w.w = pk2(v1[2], v1[3]);
                    *(u32x4*)(rowp + bj * HALF) = w; } }
    }
};
struct EpiF32Res {
    static constexpr bool PERM = false;
    const float* base; float* out; int ldc;
    __device__ __forceinline__ void operator()(const f32x4 (&acc)[2][2][4][2], const Unit& u, int wr, int wc, int fr, int fq) const {
        const int row0 = u.row0 + wr * 64 + fr, col0 = u.col0 + wc * 32 + 4 * fq;
#pragma unroll
        for (int ai = 0; ai < 2; ++ai)
#pragma unroll
            for (int m = 0; m < 4; ++m) { const size_t off = (size_t)(row0 + ai * HALF + m * 16) * ldc + col0;
#pragma unroll
                for (int bj = 0; bj < 2; ++bj)
#pragma unroll
                    for (int n = 0; n < 2; ++n) { const f32x4 bs = *(const f32x4*)(base + off + bj * HALF + n * 16); *(f32x4*)(out + off + bj * HALF + n * 16) = bs + acc[ai][bj][m][n]; } }
    }
};
template <bool BASE_F32> struct EpiResBf16 {
    static constexpr bool PERM = true;
    const void* base; bf16* out; int ldc;
    __device__ __forceinline__ void operator()(const f32x4 (&acc)[2][2][4][2], const Unit& u, int wr, int wc, int fr, int fq) const {
        const int row0 = u.row0 + wr * 64 + fr, col0 = u.col0 + wc * 32 + 8 * fq;
#pragma unroll
        for (int ai = 0; ai < 2; ++ai)
#pragma unroll
            for (int m = 0; m < 4; ++m) { const size_t off = (size_t)(row0 + ai * HALF + m * 16) * ldc + col0;
#pragma unroll
                for (int bj = 0; bj < 2; ++bj) { f32x4 b0, b1;
                    if constexpr (BASE_F32) { b0 = *(const f32x4*)((const float*)base + off + bj * HALF); b1 = *(const f32x4*)((const float*)base + off + bj * HALF + 4); }
                    else { const u32x4 t = *(const u32x4*)((const bf16*)base + off + bj * HALF); b0 = (f32x4){bflo(t.x), bfhi(t.x), bflo(t.y), bfhi(t.y)}; b1 = (f32x4){bflo(t.z), bfhi(t.z), bflo(t.w), bfhi(t.w)}; }
                    const f32x4 v0 = b0 + acc[ai][bj][m][0], v1 = b1 + acc[ai][bj][m][1];
                    u32x4 w; w.x = pk2(v0[0], v0[1]); w.y = pk2(v0[2], v0[3]); w.z = pk2(v1[0], v1[1]); w.w = pk2(v1[2], v1[3]);
                    *(u32x4*)(out + off + bj * HALF) = w; } }
    }
};
struct EpiSwiglu {
    static constexpr bool PERM = true;
    const float* bg; const float* bu;
    __device__ __forceinline__ void operator()(const f32x4 (&acc)[2][2][4][2], const Unit& u, int wr, int wc, int fr, int fq) const {
        const int rowt = wr * 64 + fr, colt = u.col0 + wc * 32 + 8 * fq;
        f32x4 g_[2], u_[2];
#pragma unroll
        for (int n = 0; n < 2; ++n) { g_[n] = *(const f32x4*)(bg + (size_t)u.e * 2048 + colt + 4 * n); u_[n] = *(const f32x4*)(bu + (size_t)u.e * 2048 + colt + 4 * n); }
#pragma unroll
        for (int ai = 0; ai < 2; ++ai)
#pragma unroll
            for (int m = 0; m < 4; ++m) { unsigned char* rowp = (unsigned char*)u.O + (size_t)(u.row0 + rowt + ai * HALF + m * 16) * 2048 + colt;
                float a[8];
#pragma unroll
                for (int n = 0; n < 2; ++n)
#pragma unroll
                    for (int j = 0; j < 4; ++j) { float g = acc[ai][0][m][n][j] + g_[n][j], up = acc[ai][1][m][n][j] + u_[n][j];
                        g = fminf(g, 7.0f); up = fminf(fmaxf(up, -7.0f), 7.0f);
                        a[n * 4 + j] = g * __builtin_amdgcn_rcpf(1.0f + __expf(-1.702f * g)) * (up + 1.0f); }
                *(u32x2*)rowp = (u32x2){pk4_fp8(a[0], a[1], a[2], a[3]), pk4_fp8(a[4], a[5], a[6], a[7])}; }
    }
};

template <class Epi, class Sched, bool GATHER, bool FP8 = false, int SCA = 0x7f7f7f7f>
__device__ __forceinline__ void gemm_phase(LAS unsigned char* lds, const Sched& S, const Epi& E) {
    const int tid = threadIdx.x, wid = __builtin_amdgcn_readfirstlane(tid >> 6), lane = tid & 63, wr = wid >> 2, wc = wid & 3, fr = lane & 15, fq = lane >> 4;
    constexpr int RP = FP8 ? 2048 : 4096, nt = RP / 128;
    unsigned voffA[2][2], voffB[2];
#pragma unroll
    for (int i = 0; i < 2; ++i) { int R, C; stage_rc(tid * 16 + i * 8192, R, C); const int Rb = Epi::PERM ? ((R & ~31) + perm32(R & 31)) : R;
        voffA[0][i] = (unsigned)(R * RP + C * 2); voffA[1][i] = (unsigned)((R + HALF) * RP + C * 2); voffB[i] = (unsigned)(Rb * RP + C * 2); }
    constexpr size_t kstep = (size_t)(BK * 2);
    constexpr size_t hstep = (size_t)HALF * RP;
    const unsigned ldsw = (unsigned)wid * 1024u;
    const int aoff = lds_byte(wr * 64 + fr, fq * 8), boff = lds_byte(wc * 32 + fr, fq * 8);
#define PG8_SA(b, h) (((b) * 2 + (h)) * HTB)
#define PG8_SB(b, h) ((4 + (b) * 2 + (h)) * HTB)
#define PG8_STAGE(bufoff, gbase, voff) do { _Pragma("unroll") for (int _i = 0; _i < 2; ++_i) \
        __builtin_amdgcn_global_load_lds((const unsigned*)((const char*)(gbase) + (voff)[_i]), (LAS unsigned*)(lds + (bufoff) + ldsw + _i * 8192), 16, 0, 0); } while (0)
#define PG8_CAT(p) __builtin_shufflevector(*(const LAS i32x4*)(p), *(const LAS i32x4*)((p) + 1024), 0, 1, 2, 3, 4, 5, 6, 7)
#define PG8_LDA(dst, b, h) do { _Pragma("unroll") for (int m = 0; m < 4; ++m) dst[m] = PG8_CAT(lds + PG8_SA(b, h) + aoff + m * 2048); } while (0)
#define PG8_LDB(dst, b, h) do { _Pragma("unroll") for (int n = 0; n < 2; ++n) dst[n] = PG8_CAT(lds + PG8_SB(b, h) + boff + n * 2048); } while (0)
#define PG8_HALF(v, k) __builtin_bit_cast(bf16x8, (k) ? __builtin_shufflevector(v, v, 4, 5, 6, 7) : __builtin_shufflevector(v, v, 0, 1, 2, 3))
#define PG8_MMA(ai, bj, At, Bt) do { __builtin_amdgcn_s_setprio(1); _Pragma("unroll") for (int m = 0; m < 4; ++m) _Pragma("unroll") for (int n = 0; n < 2; ++n) { \
        if constexpr (FP8) asm volatile("v_mfma_scale_f32_16x16x128_f8f6f4 %0, %1, %2, %0, %3, %4 op_sel_hi:[0,0,0]" : "+v"(acc[ai][bj][m][n]) : "v"(Bt[n]), "v"(At[m]), "v"(scw), "v"(sca));   \
        else { _Pragma("unroll") for (int k = 0; k < 2; ++k) acc[ai][bj][m][n] = __builtin_amdgcn_mfma_f32_16x16x32_bf16(PG8_HALF(Bt[n], k), PG8_HALF(At[m], k), acc[ai][bj][m][n], 0, 0, 0); } } \
        __builtin_amdgcn_s_setprio(0); } while (0)
#define PG8_WAIT_V(n) asm volatile("s_waitcnt vmcnt(" #n ")" ::: "memory")
#define PG8_WAIT_L(n) asm volatile("s_waitcnt lgkmcnt(" #n ")" ::: "memory")
#define PG8_BAR __builtin_amdgcn_s_barrier()
#define PG8_SCHED __builtin_amdgcn_sched_barrier(0)
#define PG8_GATHER(dst, u) do { _Pragma("unroll") for (int _i = 0; _i < 2; ++_i) { int _R, _C; stage_rc(tid * 16 + _i * 8192, _R, _C); _Pragma("unroll") for (int _h = 0; _h < 2; ++_h) { \
        const int _idx = _h * HALF + _R; const int _t = ((u).ui < 15) ? S.tokl[(u).ui * 256 + _idx] : ((_idx < (u).cnt) ? (u).tok[_idx] : 0);     \
        dst[_h][_i] = (unsigned)(_t * RP + _C * 2); } } } while (0)
    Unit cur, nxt; int ui = 0;
    if (!S.next(0, cur)) return;
    f32x4 acc[2][2][4][2];
#pragma unroll
    for (int a = 0; a < 2; ++a)
#pragma unroll
        for (int b = 0; b < 2; ++b)
#pragma unroll
            for (int m = 0; m < 4; ++m)
#pragma unroll
                for (int n = 0; n < 2; ++n) acc[a][b][m][n] = (f32x4){0.f, 0.f, 0.f, 0.f};
    int scw = 0x79797979, sca = SCA;
    asm volatile("" : "+v"(scw), "+v"(sca));
    i32x8 At[4], B0[2], B1[2];
    const char* cA = cur.A; const char* cB = cur.B;
    S.a_ready(cur);
    if constexpr (GATHER) { PG8_GATHER(voffA, cur); }
    PG8_STAGE(PG8_SB(0, 0), cB, voffB); PG8_STAGE(PG8_SB(0, 1), cB + hstep, voffB); PG8_STAGE(PG8_SA(0, 0), cA, voffA[0]); PG8_STAGE(PG8_SA(0, 1), cA, voffA[1]);
    if (wr == 1) PG8_BAR;
    PG8_WAIT_V(2); PG8_BAR;
    PG8_STAGE(PG8_SB(1, 0), cB + kstep, voffB); PG8_STAGE(PG8_SA(1, 0), cA + kstep, voffA[0]); PG8_STAGE(PG8_SB(1, 1), cB + hstep + kstep, voffB);
    PG8_WAIT_V(6); PG8_BAR;
    for (;;) {
        const bool has_next = S.next(ui + 1, nxt);
        const char* nA = has_next ? nxt.A : cA; const char* nB = has_next ? nxt.B : cB;
        for (int t = 0; t < nt; t += 2) {
            const bool last = (t == nt - 2);
            const char* a1 = cA + (size_t)(t + 1) * kstep;
            const char* a2 = last ? nA : cA + (size_t)(t + 2) * kstep; const char* b2 = last ? nB : cB + (size_t)(t + 2) * kstep;
            const char* a3 = a2 + kstep; const char* b3 = b2 + kstep;
            if (last && has_next) S.a_ready(nxt);
            PG8_LDB(B0, 0, 0); PG8_LDB(B1, 0, 1); PG8_SCHED; PG8_LDA(At, 0, 0); PG8_STAGE(PG8_SA(1, 1), a1, voffA[1]);
            PG8_WAIT_V(8); PG8_WAIT_L(0); PG8_BAR; PG8_MMA(0, 0, At, B0); PG8_MMA(0, 1, At, B1); PG8_BAR; PG8_SCHED;
            if constexpr (GATHER) { if (last && has_next) { PG8_GATHER(voffA, nxt); } }
            PG8_LDA(At, 0, 1); PG8_STAGE(PG8_SB(0, 0), b2, voffB); PG8_STAGE(PG8_SB(0, 1), b2 + hstep, voffB); PG8_STAGE(PG8_SA(0, 0), a2, voffA[0]);
            PG8_WAIT_V(8); PG8_WAIT_L(0); PG8_BAR; PG8_MMA(1, 0, At, B0); PG8_MMA(1, 1, At, B1); PG8_BAR; PG8_SCHED;
            PG8_LDB(B0, 1, 0); PG8_LDB(B1, 1, 1); PG8_SCHED; PG8_LDA(At, 1, 0); PG8_STAGE(PG8_SA(0, 1), a2, voffA[1]);
            PG8_WAIT_V(8); PG8_WAIT_L(0); PG8_BAR; PG8_MMA(0, 0, At, B0); PG8_MMA(0, 1, At, B1); PG8_BAR; PG8_SCHED;
            PG8_LDA(At, 1, 1); PG8_STAGE(PG8_SB(1, 0), b3, voffB); PG8_STAGE(PG8_SB(1, 1), b3 + hstep, voffB); PG8_STAGE(PG8_SA(1, 0), a3, voffA[0]);
            PG8_WAIT_V(8); PG8_WAIT_L(0); PG8_BAR; PG8_MMA(1, 0, At, B0); PG8_MMA(1, 1, At, B1); PG8_BAR; PG8_SCHED;
        }
        if (wr == 0) PG8_BAR;
        if constexpr (FP8) { asm volatile("s_nop 15\n\ts_nop 15" ::: "memory");
#pragma unroll
            for (int a_ = 0; a_ < 2; ++a_)
#pragma unroll
                for (int b_ = 0; b_ < 2; ++b_)
#pragma unroll
                    for (int m_ = 0; m_ < 4; ++m_)
#pragma unroll
                        for (int n_ = 0; n_ < 2; ++n_) asm volatile("" : "+v"(acc[a_][b_][m_][n_])); }
        E(acc, cur, wr, wc, fr, fq);
        if (!has_next) break;
#pragma unroll
        for (int a = 0; a < 2; ++a)
#pragma unroll
            for (int b = 0; b < 2; ++b)
#pragma unroll
                for (int m = 0; m < 4; ++m)
#pragma unroll
                    for (int n = 0; n < 2; ++n) acc[a][b][m][n] = (f32x4){0.f, 0.f, 0.f, 0.f};
        cur = nxt; cA = nA; cB = nB; ++ui;
        if (wr == 1) PG8_BAR;
    }
    PG8_WAIT_V(0);
    PG8_BAR;
#undef PG8_SA
#undef PG8_SB
#undef PG8_STAGE
#undef PG8_LDA
#undef PG8_CAT
#undef PG8_HALF
#undef PG8_LDB
#undef PG8_MMA
#undef PG8_WAIT_V
#undef PG8_WAIT_L
#undef PG8_BAR
#undef PG8_SCHED
#undef PG8_GATHER
}
}

#define XB_TMO      128
#define XB_XCNT(j)  (256  + 64 * (j))
#define XB_XSUB(j)  (1280 + 64 * (j))
#define XB_XGEN(j)  (2304 + 64 * (j))
#define XB_TOP      3328
#define XB_TOPGEN   3392
#define XCD_BAR_WORDS 3456
#define XB_SPIN_CAP (1u << 18)
__device__ __forceinline__ unsigned xb_ld(unsigned* p)              { return __hip_atomic_load(p, __ATOMIC_RELAXED, __HIP_MEMORY_SCOPE_AGENT); }
__device__ __forceinline__ unsigned xb_add(unsigned* p, unsigned v) { return __hip_atomic_fetch_add(p, v, __ATOMIC_RELAXED, __HIP_MEMORY_SCOPE_AGENT); }
__device__ __forceinline__ unsigned xb_xcc_id() { return (unsigned)__builtin_amdgcn_s_getreg((3 << 11) | 20) & 0xFu; }
#define XB_SPIN(cond, bar) do { unsigned _sp = 0; while (cond) { __builtin_amdgcn_s_sleep(1); \
    if ((++_sp & 255u) == 0u) { if (xb_ld(&(bar)[XB_TMO])) break; if (_sp > XB_SPIN_CAP) { atomicAdd(&(bar)[XB_TMO], 1u); break; } } } } while (0)
struct XcdBarrier { unsigned* bar; unsigned x; volatile LAS unsigned* st; };
__device__ __forceinline__ XcdBarrier xcd_barrier_post(unsigned* bar, volatile LAS unsigned* st) {
    XcdBarrier b; b.bar = bar; b.x = xb_xcc_id(); b.st = st;
    if (threadIdx.x == 0) (void)xb_add(&bar[XB_XCNT(b.x)], 1u);
    return b;
}
__device__ __forceinline__ void xcd_barrier_complete(unsigned* bar, unsigned x, unsigned& nloc, unsigned& nx) {
    const unsigned G = gridDim.x * gridDim.y * gridDim.z;
    unsigned sum, cnt, mine, sp = 0u;
    for (;;) {
        sum = 0u; cnt = 0u; mine = 0u;
#pragma unroll
        for (unsigned j = 0; j < 16; ++j) { const unsigned c = xb_ld(&bar[XB_XCNT(j)]); sum += c; cnt += (c > 0u) ? 1u : 0u; mine = (j == x) ? c : mine; }
        if (sum == G) break;
        __builtin_amdgcn_s_sleep(1);
        if ((++sp & 255u) == 0u) { if (xb_ld(&bar[XB_TMO])) break; if (sp > XB_SPIN_CAP) { atomicAdd(&bar[XB_TMO], 1u); break; } }
    }
    nloc = mine > 0u ? mine : 1u; nx = cnt > 0u ? cnt : 1u;
}
__device__ __forceinline__ void xcd_barrier(const XcdBarrier& b) {
    asm volatile("s_waitcnt vmcnt(0)" ::: "memory");
    __syncthreads();
    if (threadIdx.x == 0) {
        unsigned* bar = b.bar;
        __builtin_amdgcn_s_waitcnt(0);
        unsigned nloc = b.st[0], nx = b.st[1];
        if (nloc == 0u) { xcd_barrier_complete(bar, b.x, nloc, nx); b.st[0] = nloc; b.st[1] = nx; }
        const unsigned old = xb_add(&bar[XB_XSUB(b.x)], 1u);
        const unsigned gen = old / nloc;
        if (old + 1u == (gen + 1u) * nloc) {
            __builtin_amdgcn_fence(__ATOMIC_RELEASE, "agent");
            asm volatile("s_waitcnt vmcnt(0)" ::: "memory");
            const unsigned og = xb_add(&bar[XB_TOP], 1u);
            const unsigned tg = og / nx;
            if (og + 1u == (tg + 1u) * nx) xb_add(&bar[XB_TOPGEN], 1u);
            else XB_SPIN(xb_ld(&bar[XB_TOPGEN]) == tg, bar);
            __builtin_amdgcn_fence(__ATOMIC_ACQUIRE, "agent");
            xb_add(&bar[XB_XGEN(b.x)], 1u);
            asm volatile("s_waitcnt vmcnt(0)" ::: "memory");
        } else {
            XB_SPIN(xb_ld(&bar[XB_XGEN(b.x)]) == gen, bar);
            __builtin_amdgcn_fence(__ATOMIC_ACQUIRE, "agent");
            asm volatile("s_waitcnt vmcnt(0)" ::: "memory");
        }
    }
    __syncthreads();
}

struct Args {
    const float* in[28];
    float* out; unsigned char* ws;
    int ph_lo, ph_hi, li, pad;
};
enum { I_X = 0, I_MEM, I_NORM_MIX, I_W_IN, I_CONV_W, I_CONV_B, I_DT_BIAS, I_A_LOG, I_D_SKIP, I_SSD_NORM, I_POOL_W, I_POOL_SCALE, I_W_OUT, I_NORM_XATTN, I_NORM_MEM,
       I_W_Q, I_W_KV, I_W_O, I_NORM_FFN, I_W_ROUTER, I_B_ROUTER, I_W_GATE, I_B_GATE, I_W_UP, I_B_UP, I_W_DOWN, I_B_DOWN, I_NORM_FINAL };

template <int MT, int NT>
__device__ __forceinline__ void wave_mma(f32x4 (&acc)[MT][NT], const LAS bf16* A, int lda, const LAS bf16* Bt, int ldb, int K, int lane) {
    const int fr = lane & 15, fq = lane >> 4;
    for (int k0 = 0; k0 < K; k0 += 32) {
        bf16x8 a[MT], b[NT];
#pragma unroll
        for (int m = 0; m < MT; ++m) a[m] = *(const LAS bf16x8*)(A + (m * 16 + fr) * lda + k0 + fq * 8);
#pragma unroll
        for (int n = 0; n < NT; ++n) b[n] = *(const LAS bf16x8*)(Bt + (n * 16 + fr) * ldb + k0 + fq * 8);
#pragma unroll
        for (int m = 0; m < MT; ++m)
#pragma unroll
            for (int n = 0; n < NT; ++n) acc[m][n] = __builtin_amdgcn_mfma_f32_16x16x32_bf16(b[n], a[m], acc[m][n], 0, 0, 0);
    }
}
__device__ __forceinline__ void tile_g2l(LAS bf16* dst, int ldd, const bf16* src, size_t lds_, int rows, int cols, int tid) {
    const int vpr = cols >> 3, nv = rows * vpr;
    for (int i = tid; i < nv; i += NTHREADS) { const int r = i / vpr, c = i - r * vpr; *(LAS u32x4*)(dst + r * ldd + c * 8) = *(const u32x4*)(src + (size_t)r * lds_ + c * 8); }
}

constexpr int CW_RDY = 24576;
constexpr int CW_TMO = 2;
constexpr int CONV_RDY_TARGET = 1024;
struct ConvItem { const float* sp; unsigned char* dst; unsigned nbytes; int drow0, kb2, ldw; };
__device__ __forceinline__ void conv_decode(const Args& a, int it, int lane, ConvItem& c) {
    unsigned char* ws = a.ws; constexpr int GU_ITEMS = NE * 1024; const float* src; int nb; c.ldw = 2048;
    if (it < GU_ITEMS) { const int e = it >> 10, r = it & 1023, up = r >> 9, r2 = r & 511; c.kb2 = r2 >> 5; nb = r2 & 31;
        src = (up ? a.in[I_W_UP] : a.in[I_W_GATE]) + (size_t)e * 2048 * 2048; c.dst = ws + WS_WGU + (size_t)e * 4096 * 2048; c.nbytes = 4096u * 2048u;
        const int n0 = nb * 64; c.drow0 = (n0 >> 7) * 256 + (n0 & 127) + (up ? 128 : 0); }
    else if (it < NE * 1536) { const int q = it - GU_ITEMS; const int e = q >> 9, r2 = q & 511; c.kb2 = r2 >> 5; nb = r2 & 31;
        src = a.in[I_W_DOWN] + (size_t)e * 2048 * 2048; c.dst = ws + WS_WD + (size_t)e * 2048 * 2048; c.nbytes = 2048u * 2048u; c.drow0 = nb * 64; }
    else { const int q = it - NE * 1536; const int mtx = q >> 9, r2 = q & 511; c.kb2 = r2 >> 5; nb = r2 & 31; c.nbytes = 2048u * 2048u; c.drow0 = nb * 64;
        if (mtx == 0) { src = a.in[I_W_Q]; c.dst = ws + WS_WQ; } else if (mtx == 1) { src = a.in[I_W_O]; c.dst = ws + WS_WO; }
        else if (mtx == 2) { src = a.in[I_W_KV]; c.dst = ws + WS_WK; c.ldw = 4096; } else { src = a.in[I_W_KV] + 2048; c.dst = ws + WS_WV; c.ldw = 4096; } }
    c.sp = src + (size_t)(c.kb2 * 128) * c.ldw + nb * 64 + lane;
}
#define CONV_LOAD(v, c, h) do { _Pragma("unroll") for (int i_ = 0; i_ < 64; ++i_) v[i_] = __builtin_nontemporal_load((c).sp + (size_t)((h) * 64 + i_) * (c).ldw); } while (0)
#define CONV_PACK(v, t) do { _Pragma("unroll") for (int q_ = 0; q_ < 4; ++q_) { \
        t[q_].x = pk4_fp8(v[16 * q_ + 0] * 64.0f, v[16 * q_ + 1] * 64.0f, v[16 * q_ + 2] * 64.0f, v[16 * q_ + 3] * 64.0f); \
        t[q_].y = pk4_fp8(v[16 * q_ + 4] * 64.0f, v[16 * q_ + 5] * 64.0f, v[16 * q_ + 6] * 64.0f, v[16 * q_ + 7] * 64.0f); \
        t[q_].z = pk4_fp8(v[16 * q_ + 8] * 64.0f, v[16 * q_ + 9] * 64.0f, v[16 * q_ + 10] * 64.0f, v[16 * q_ + 11] * 64.0f); \
        t[q_].w = pk4_fp8(v[16 * q_ + 12] * 64.0f, v[16 * q_ + 13] * 64.0f, v[16 * q_ + 14] * 64.0f, v[16 * q_ + 15] * 64.0f); } } while (0)
__device__ __forceinline__ void moe_convert(const Args& a, LAS unsigned char* lds, int cw, int NCW, int lane, int wave) {
    constexpr int ALL_ITEMS = NE * 1536 + 4 * 512;
    LAS unsigned char* my = lds + wave * 9216;
    float va[64], vb[64]; ConvItem c;
    int it = cw;
    if (it < ALL_ITEMS) { conv_decode(a, it, lane, c); CONV_LOAD(va, c, 0); CONV_LOAD(vb, c, 1); }
    while (it < ALL_ITEMS) {
        u32x4 hold[4];
        CONV_PACK(va, hold);
#pragma unroll
        for (int q = 0; q < 4; ++q) asm volatile("" : "+v"(hold[q]));
        unsigned char* dstp = c.dst; const unsigned nbytes = c.nbytes; const unsigned voff = (unsigned)((c.drow0 + (lane >> 3)) * 2048 + c.kb2 * 128 + 16 * (lane & 7));
        it += NCW;
        if (it < ALL_ITEMS) { conv_decode(a, it, lane, c); CONV_LOAD(va, c, 0); }
        u32x4 t[4];
        CONV_PACK(vb, t);
#pragma unroll
        for (int q = 0; q < 4; ++q) { *(LAS u32x4*)(my + lane * 144 + 16 * q) = hold[q]; *(LAS u32x4*)(my + lane * 144 + 64 + 16 * q) = t[q]; }
        LDS_WAIT(); __builtin_amdgcn_wave_barrier();
        u32x4 o[8];
#pragma unroll
        for (int j = 0; j < 8; ++j) o[j] = *(const LAS u32x4*)(my + (8 * j + (lane >> 3)) * 144 + 16 * (lane & 7));
        LDS_WAIT(); __builtin_amdgcn_wave_barrier();
        const __amdgpu_buffer_rsrc_t rs = __builtin_amdgcn_make_buffer_rsrc((void*)dstp, 0, nbytes, 0x00020000);
#pragma unroll
        for (int j = 0; j < 8; ++j) __builtin_amdgcn_raw_buffer_store_b128(o[j], rs, voff + (unsigned)(8 * j * 2048), 0, 0);
        if (it < ALL_ITEMS) { CONV_LOAD(vb, c, 1); }
    }
}

__device__ __forceinline__ void transpose_block(const float* W, int ldw, int k0, bf16* dstrow, int Kd, int lane, int nvalid, LAS unsigned char* my) {
    float v[64];
    const float* s = W + (size_t)k0 * ldw + (lane < nvalid ? lane : 0);
#pragma unroll
    for (int i = 0; i < 64; ++i) v[i] = s[(size_t)i * ldw];
#pragma unroll
    for (int j = 0; j < 8; ++j) { u32x4 o; o.x = pk2(v[8 * j], v[8 * j + 1]); o.y = pk2(v[8 * j + 2], v[8 * j + 3]); o.z = pk2(v[8 * j + 4], v[8 * j + 5]); o.w = pk2(v[8 * j + 6], v[8 * j + 7]);
        *(LAS u32x4*)(my + lane * 144 + 16 * j) = o; }
    LDS_WAIT(); __builtin_amdgcn_wave_barrier();
#pragma unroll
    for (int j = 0; j < 8; ++j) { const int r = 8 * j + (lane >> 3); const u32x4 o = *(const LAS u32x4*)(my + r * 144 + 16 * (lane & 7));
        if (r < nvalid) *(u32x4*)(dstrow + (size_t)r * Kd + k0 + 8 * (lane & 7)) = o; }
    LDS_WAIT(); __builtin_amdgcn_wave_barrier();
}
struct ConvDesc { const float* src; bf16* dst; int ldw, K, srccol0, ncb, nexp, mode; size_t src_es, dst_es; };

__device__ __forceinline__ void conv_matrix(const ConvDesc& d, int gw, int NGW, int lane, LAS unsigned char* my) {
    const int nkb = d.K / 64, per = nkb * d.ncb, total = per * d.nexp;
    for (int it = gw; it < total; it += NGW) {
        const int e = it / per, r = it - e * per, kb = r / d.ncb, nb = r - kb * d.ncb;
        const int n0 = nb * 64;
        int drow = n0;
        if (d.mode) drow = (n0 >> 7) * 256 + (n0 & 127) + (d.mode == 2 ? 128 : 0);
        transpose_block(d.src + (size_t)e * d.src_es + d.srccol0 + n0, d.ldw, kb * 64, d.dst + (size_t)e * d.dst_es + (size_t)drow * d.K, d.K, lane, 64, my);
    }
}

#if defined(P0_PROBE) && P0_PROBE < 3
__device__ __forceinline__ void p0_probe(const Args& a, int gw, int NGW, int lane) {
    float acc = 0.f;
#if P0_PROBE == 1
    constexpr int ALL_ITEMS = NE * 1024 + NE * 512;
    for (int it = gw; it < ALL_ITEMS; it += NGW) {
        int e, kb, nb; const float* src;
        if (it < NE * 1024) { e = it >> 10; const int r = it & 1023, up = r >> 9, r2 = r & 511; kb = r2 >> 4; nb = r2 & 15; src = (up ? a.in[I_W_UP] : a.in[I_W_GATE]) + (size_t)e * 2048 * 2048; }
        else { const int q = it - NE * 1024; e = q >> 9; const int r2 = q & 511; kb = r2 >> 4; nb = r2 & 15; src = a.in[I_W_DOWN] + (size_t)e * 2048 * 2048; }
        const f32x2* sp = (const f32x2*)(src + (size_t)(kb * 64) * 2048 + nb * 128) + lane;
        f32x2 v[64];
#pragma unroll
        for (int i = 0; i < 64; ++i) v[i] = sp[(size_t)i * 1024];
#pragma unroll
        for (int i = 0; i < 64; ++i) acc += v[i].x + v[i].y;
    }
#elif P0_PROBE == 2
    constexpr int ALL_ITEMS = NE * 3 * 64 * 8;
    for (int it0 = gw; it0 < NE * 3 * 8; it0 += NGW) {
        const int mat = it0 >> 3, strip = it0 & 7; const int e = mat / 3, wh = mat % 3;
        const float* src = (wh == 0 ? a.in[I_W_GATE] : wh == 1 ? a.in[I_W_UP] : a.in[I_W_DOWN]) + (size_t)e * 2048 * 2048 + strip * 256;
        for (int kb = 0; kb < 64; ++kb) {
            const f32x4* sp = (const f32x4*)(src + (size_t)(kb * 32) * 2048) + lane;
            f32x4 v[32];
#pragma unroll
            for (int i = 0; i < 32; ++i) v[i] = sp[(size_t)i * 512];
#pragma unroll
            for (int i = 0; i < 32; ++i) acc += (v[i].x + v[i].y) + (v[i].z + v[i].w);
        }
    }
    (void)ALL_ITEMS;
#endif
    if (acc == 1.2345e-30f) ((float*)(a.ws + WS_CTL))[20] = acc;
}
#endif
__device__ __forceinline__ void p0_prologue(const Args& a, LAS unsigned char* lds, int tid, int lane, int wave, int vcu, int G) {
    unsigned char* ws = a.ws;
    const int gw = vcu * NWAVES + wave, NGW = G * NWAVES;
#ifdef P0_PROBE
    if (a.pad == 1) { p0_probe(a, gw, NGW, lane); return; }
#endif
    {
        ConvDesc d;
        d = ConvDesc{a.in[I_W_IN], (bf16*)(ws + WS_WIN), DIN, 2048, 0, 48, 1, 0, 0, 0}; conv_matrix(d, gw, NGW, lane, lds + wave * 9216);
        d = ConvDesc{a.in[I_W_IN], (bf16*)(ws + WS_WIN) + (size_t)3072 * 2048, DIN, 2048, 3088, 16, 1, 0, 0, 0}; conv_matrix(d, gw, NGW, lane, lds + wave * 9216);
        d = ConvDesc{a.in[I_W_OUT], (bf16*)(ws + WS_WOUT), 2048, 2048, 0, 32, 1, 0, 0, 0}; conv_matrix(d, gw, NGW, lane, lds + wave * 9216);
        d = ConvDesc{a.in[I_POOL_W], (bf16*)(ws + WS_PW), 256, 256, 0, 4, 4, 0, (size_t)256 * 256, (size_t)256 * 256}; conv_matrix(d, gw, NGW, lane, lds + wave * 9216);
        moe_convert(a, lds, gw, NGW, lane, wave);
        __syncthreads();
        for (int kb = gw; kb < 32; kb += NGW) transpose_block(a.in[I_W_ROUTER], 32, kb * 64, (bf16*)(ws + WS_WR), 2048, lane, 32, lds + wave * 9216);
    }
    __syncthreads();
    constexpr int WP = 2052;
    LAS float* wdt = (LAS float*)lds;
    {
        const float* w_in = a.in[I_W_IN];
        for (int i = tid; i < 2048 * 16; i += NTHREADS) { const int k = i >> 4, h = i & 15; wdt[h * WP + k] = w_in[(size_t)k * DIN + 3072 + h]; }
    }
    __syncthreads();
    {
        const float* x = a.in[I_X]; const float* nw = a.in[I_NORM_MIX];
        bf16* hn = (bf16*)(ws + WS_HN); float* dtraw = (float*)(ws + WS_DTRAW);
        f32x4 wv[8];
#pragma unroll
        for (int j = 0; j < 8; ++j) wv[j] = ((const f32x4*)nw)[lane + 64 * j];
        for (int m = gw; m < T; m += NGW) {
            const f32x4* xr = (const f32x4*)(x + (size_t)m * D) + lane;
            f32x4 v[8]; float ss = 0.f;
#pragma unroll
            for (int j = 0; j < 8; ++j) { v[j] = xr[64 * j]; ss += (v[j].x * v[j].x + v[j].y * v[j].y) + (v[j].z * v[j].z + v[j].w * v[j].w); }
            const float rstd = rsqrtf(wave_sum(ss) * (1.f / D) + EPS);
            u32x2* o8 = (u32x2*)(hn + (size_t)m * D) + lane;
#pragma unroll
            for (int j = 0; j < 8; ++j) { v[j] = v[j] * rstd * wv[j]; u32x2 w; w.x = pk2(v[j].x, v[j].y); w.y = pk2(v[j].z, v[j].w); o8[64 * j] = w; }
            float res = 0.f;
#pragma unroll 1
            for (int h = 0; h < 16; ++h) {
                const LAS f32x4* wr = (const LAS f32x4*)(wdt + h * WP) + lane; float p = 0.f;
#pragma unroll
                for (int j = 0; j < 8; ++j) { const f32x4 w4 = wr[64 * j]; p += (v[j].x * w4.x + v[j].y * w4.y) + (v[j].z * w4.z + v[j].w * w4.w); }
                p = wave_sum(p); if (lane == h) res = p;
            }
            if (lane < 16) dtraw[(size_t)m * 16 + lane] = res;
        }
    }
    {
        const float* x = a.in[I_MEM]; const float* nw = a.in[I_NORM_MEM]; bf16* o = (bf16*)(ws + WS_MEMN);
        for (int m = gw; m < NB * NMEM; m += NGW) {
            const f32x4* xr = (const f32x4*)(x + (size_t)m * D) + lane;
            f32x4 v[8]; float ss = 0.f;
#pragma unroll
            for (int j = 0; j < 8; ++j) { v[j] = xr[64 * j]; ss += (v[j].x * v[j].x + v[j].y * v[j].y) + (v[j].z * v[j].z + v[j].w * v[j].w); }
            const float rstd = rsqrtf(wave_sum(ss) * (1.f / D) + EPS);
            unsigned* o4 = (unsigned*)((unsigned char*)o + (size_t)m * D) + lane;
#pragma unroll
            for (int j = 0; j < 8; ++j) { const f32x4 w4 = ((const f32x4*)nw)[lane + 64 * j]; v[j] = v[j] * rstd * w4; o4[64 * j] = pk4_fp8(v[j].x, v[j].y, v[j].z, v[j].w); }
        }
    }
}

__device__ __forceinline__ f32x4 ld_row4(const bf16* row, int lane, int j) { const u32x2 t = ((const u32x2*)row)[lane + 64 * j]; return (f32x4){bflo(t.x), bfhi(t.x), bflo(t.y), bfhi(t.y)}; }
__device__ __forceinline__ void rms_rows_bf16(const bf16* src, const float* nw, bf16* o, int rows, int gw, int NGW, int lane) {
    f32x4 wv[8];
#pragma unroll
    for (int j = 0; j < 8; ++j) wv[j] = ((const f32x4*)nw)[lane + 64 * j];
    for (int m = gw; m < rows; m += NGW) {
        const bf16* xr = src + (size_t)m * D;
        f32x4 v[8]; float ss = 0.f;
#pragma unroll
        for (int j = 0; j < 8; ++j) { v[j] = ld_row4(xr, lane, j); ss += (v[j].x * v[j].x + v[j].y * v[j].y) + (v[j].z * v[j].z + v[j].w * v[j].w); }
        const float rstd = rsqrtf(wave_sum(ss) * (1.f / D) + EPS);
        unsigned* o4 = (unsigned*)((unsigned char*)o + (size_t)m * D) + lane;
#pragma unroll
        for (int j = 0; j < 8; ++j) { v[j] = v[j] * rstd * wv[j]; o4[64 * j] = pk4_fp8(v[j].x, v[j].y, v[j].z, v[j].w); }
    }
}

struct DenseSched {
    const char* A; const char* B; char* O; int ldc; int nM, nN, nwg, G, c; int rp = 4096; const LAS int* tokl = nullptr;
    __device__ __forceinline__ void a_ready(const pg8::Unit&) const {}
    __device__ __forceinline__ void decode(int L, int& pm, int& pn) const {
        int wgid = L; { const int q = nwg / 8, r = nwg % 8, xcd = wgid % 8, off = wgid / 8; wgid = (xcd < r ? xcd * (q + 1) : r * (q + 1) + (xcd - r) * q) + off; }
        const int nig = 8 * nN, gid = wgid / nig, fm = gid * 8, gsz = (nM - fm) < 8 ? (nM - fm) : 8;
        pm = fm + ((wgid % nig) % gsz); pn = (wgid % nig) / gsz;
    }
    __device__ __forceinline__ bool next(int i, pg8::Unit& u) const {
        const int L = i * G + c; if (L >= nwg) return false;
        int pm, pn; decode(L, pm, pn);
        u.A = A + (size_t)pm * 256 * rp; u.B = B + (size_t)pn * 256 * rp; u.O = O; u.ldc = ldc; u.row0 = pm * 256; u.col0 = pn * 256; u.e = 0; u.cnt = 0; u.tok = nullptr; u.ui = i;
        return true;
    }
};
struct KvSched {
    const char* memn; const char* wk; const char* wv; char* kmem; char* vt; int G, c; const LAS int* tokl = nullptr;
    __device__ __forceinline__ void a_ready(const pg8::Unit&) const {}
    __device__ __forceinline__ bool next(int i, pg8::Unit& u) const {
        const int r = i * G + c; if (r >= 32) return false;
        u.e = 0; u.cnt = 0; u.tok = nullptr; u.ui = i;
        if (r < 16) { const int pm = r & 1, pn = r >> 1; u.A = memn + (size_t)pm * 256 * 2048; u.B = wk + (size_t)pn * 256 * 2048; u.O = kmem; u.ldc = 2048; u.row0 = pm * 256; u.col0 = pn * 256; }
        else { const int q = r - 16, pm = q >> 1, pn = q & 1; u.A = wv + (size_t)pm * 256 * 2048; u.B = memn + (size_t)pn * 256 * 2048; u.O = vt; u.ldc = 512; u.row0 = pm * 256; u.col0 = pn * 256; }
        return true;
    }
};
struct MoeSched {
    const LAS int* tstart; const int* cnt; const int* tok; const char* A; const char* B; char* O; int nN, colw, G, c; size_t b_es; bool gather; unsigned* rdy; const LAS int* tokl;
    __device__ __forceinline__ void a_ready(const pg8::Unit& u) const {
        if (rdy == nullptr) return;
        if (threadIdx.x < 64) {
            unsigned* tmo = rdy - 24576 + 2;
            const unsigned long long t0 = __builtin_amdgcn_s_memrealtime(); unsigned polls = 0;
            while ((unsigned)__builtin_amdgcn_readfirstlane(__hip_atomic_load(rdy + 64 * u.e, __ATOMIC_RELAXED, __HIP_MEMORY_SCOPE_AGENT)) < 1024u) {
                if ((++polls & 255u) == 0u && __builtin_amdgcn_readfirstlane(__hip_atomic_load(tmo, __ATOMIC_RELAXED, __HIP_MEMORY_SCOPE_AGENT)) != 0u) break;
                if (__builtin_amdgcn_s_memrealtime() - t0 > 2000000ull) { if (threadIdx.x == 0) __hip_atomic_store(tmo, 1u, __ATOMIC_RELAXED, __HIP_MEMORY_SCOPE_AGENT); break; }
                __builtin_amdgcn_s_sleep(2); }
            __builtin_amdgcn_fence(__ATOMIC_ACQUIRE, "agent");
            asm volatile("s_waitcnt vmcnt(0)" ::: "memory");
        }
        asm volatile("" ::: "memory"); __builtin_amdgcn_s_barrier(); asm volatile("" ::: "memory");
    }
    __device__ __forceinline__ bool next(int i, pg8::Unit& u) const {
        const int L = i * G + c; const int ntile = tstart[NE];
        if (L >= ntile * nN) return false;
        const int mg = L / nN, pn = L - mg * nN;
        int e = 0;
#pragma unroll 1
        for (int j = 1; j < NE; ++j) e += (tstart[j] <= mg) ? 1 : 0;
        const int mt = mg - tstart[e];
        u.e = e; u.cnt = cnt[64 * e] - mt * 256; u.tok = tok + e * 8192 + mt * 256; u.ui = i;
        u.A = gather ? A : A + (size_t)mg * 256 * 2048; u.B = B + (size_t)e * b_es + (size_t)pn * 256 * 2048; u.O = O; u.ldc = 2048; u.row0 = mg * 256; u.col0 = pn * colw;
        return true;
    }
};

constexpr int LD1 = 136;
__device__ __forceinline__ void ssd_chunk_unit(const Args& a, LAS unsigned char* lds, int unit, int tid, int lane, int wave) {
    unsigned char* ws = a.ws;
    const int g = unit & 3, c = (unit >> 2) & 31, b = unit >> 7;
    const int t0 = b * SEQ + c * CHUNK;
    const bf16* P = (const bf16*)(ws + WS_P);
    const float* conv_w = a.in[I_CONV_W]; const float* conv_b = a.in[I_CONV_B];
    LAS bf16* Cm = (LAS bf16*)lds;
    LAS bf16* Bm = (LAS bf16*)(lds + 34816);
    LAS bf16* BmT = (LAS bf16*)(lds + 69632);
    LAS bf16* XT = (LAS bf16*)lds;
    LAS bf16* Gs = (LAS bf16*)(lds + 104448);
    LAS float* dts = (LAS float*)(lds + 139264);
    LAS float* acss = dts + 512;
    LAS float* wls = acss + 512;
    const int fr = lane & 15, fq = lane >> 4;
    {
        const int half = tid >> 8, cc = tid & 255; const bool isC = cc >= 128; const int n = cc & 127;
        const int ch = (isC ? 1536 : 1024) + g * 128 + n;
        const float w0 = conv_w[ch], w1 = conv_w[DCONV + ch], w2 = conv_w[2 * DCONV + ch], w3 = conv_w[3 * DCONV + ch], cb = conv_b[ch];
        const int l0 = half * 64;
        const bf16* src = P + (size_t)t0 * PCOLS + 1024 + ch;
        float r0, r1, r2;
        { const int s = c * CHUNK + l0;
          r0 = (s - 3 >= 0) ? bf2f(src[(ptrdiff_t)(l0 - 3) * PCOLS]) : 0.f; r1 = (s - 2 >= 0) ? bf2f(src[(ptrdiff_t)(l0 - 2) * PCOLS]) : 0.f; r2 = (s - 1 >= 0) ? bf2f(src[(ptrdiff_t)(l0 - 1) * PCOLS]) : 0.f; }
        bf16* cmg = (bf16*)(ws + WS_CMG);
#pragma unroll 1
        for (int o = 0; o < 8; ++o) {
            float raw[8], ov[8];
#pragma unroll
            for (int i = 0; i < 8; ++i) raw[i] = bf2f(src[(size_t)(l0 + o * 8 + i) * PCOLS]);
#pragma unroll
            for (int i = 0; i < 8; ++i) { const float v = w0 * r0 + w1 * r1 + w2 * r2 + w3 * raw[i] + cb; ov[i] = siluf(v); r0 = r1; r1 = r2; r2 = raw[i]; }
            unsigned pk[4];
#pragma unroll
            for (int i = 0; i < 4; ++i) pk[i] = pk2(ov[2 * i], ov[2 * i + 1]);
            const int l = l0 + o * 8;
            if (!isC) {
                *(LAS u32x4*)(BmT + n * LD1 + l) = (u32x4){pk[0], pk[1], pk[2], pk[3]};
#pragma unroll
                for (int i = 0; i < 8; ++i) Bm[(l + i) * LD1 + n] = (bf16)((i & 1) ? (pk[i >> 1] >> 16) : (pk[i >> 1] & 0xffffu));
            } else {
#pragma unroll
                for (int i = 0; i < 8; ++i) { const bf16 hv = (bf16)((i & 1) ? (pk[i >> 1] >> 16) : (pk[i >> 1] & 0xffffu)); Cm[(l + i) * LD1 + n] = hv; cmg[(size_t)(t0 + l + i) * 512 + g * 128 + n] = hv; }
            }
        }
    }
    if (wave < 4) {
        const int h = g * 4 + wave;
        const float* dtraw = (const float*)(ws + WS_DTRAW);
        const float bias = a.in[I_DT_BIAS][h], av = -__expf(a.in[I_A_LOG][h]);
        float d0 = dtraw[(size_t)(t0 + 2 * lane) * 16 + h] + bias, d1 = dtraw[(size_t)(t0 + 2 * lane + 1) * 16 + h] + bias;
        d0 = d0 > 20.f ? d0 : log1pf(__expf(d0)); d1 = d1 > 20.f ? d1 : log1pf(__expf(d1));
        const float v0 = d0 * av, v1 = d1 * av;
        float s = v0 + v1;
#pragma unroll
        for (int o = 1; o < 64; o <<= 1) { const float t = __shfl_up(s, o); if (lane >= o) s += t; }
        const float acs1 = s, acs0 = s - v1;
        const float last = __shfl(s, 63);
        dts[wave * 128 + 2 * lane] = d0; dts[wave * 128 + 2 * lane + 1] = d1;
        acss[wave * 128 + 2 * lane] = acs0; acss[wave * 128 + 2 * lane + 1] = acs1;
        wls[wave * 128 + 2 * lane] = __expf(last - acs0) * d0; wls[wave * 128 + 2 * lane + 1] = __expf(last - acs1) * d1;
        float* acsg = (float*)(ws + WS_ACS);
        acsg[(size_t)(t0 + 2 * lane) * 16 + h] = acs0; acsg[(size_t)(t0 + 2 * lane + 1) * 16 + h] = acs1;
        if (lane == 0) ((float*)(ws + WS_CDEC))[(b * NCH + c) * 16 + h] = __expf(last);
    }
    __syncthreads();
    f32x4 cbv[1][8];
#pragma unroll
    for (int n = 0; n < 8; ++n) cbv[0][n] = (f32x4){0.f, 0.f, 0.f, 0.f};
    wave_mma<1, 8>(cbv, Cm + wave * 16 * LD1, LD1, Bm, LD1, 128, lane);
    __syncthreads();
    {
        const int half = tid >> 8, cc = tid & 255;
        const int ch = g * 256 + cc;
        const float w0 = conv_w[ch], w1 = conv_w[DCONV + ch], w2 = conv_w[2 * DCONV + ch], w3 = conv_w[3 * DCONV + ch], cb = conv_b[ch];
        const int l0 = half * 64;
        const bf16* src = P + (size_t)t0 * PCOLS + 1024 + ch;
        float r0, r1, r2;
        { const int s = c * CHUNK + l0;
          r0 = (s - 3 >= 0) ? bf2f(src[(ptrdiff_t)(l0 - 3) * PCOLS]) : 0.f; r1 = (s - 2 >= 0) ? bf2f(src[(ptrdiff_t)(l0 - 2) * PCOLS]) : 0.f; r2 = (s - 1 >= 0) ? bf2f(src[(ptrdiff_t)(l0 - 1) * PCOLS]) : 0.f; }
        bf16* xs = (bf16*)(ws + WS_XS);
#pragma unroll 1
        for (int o = 0; o < 8; ++o) {
            float raw[8], ov[8];
#pragma unroll
            for (int i = 0; i < 8; ++i) raw[i] = bf2f(src[(size_t)(l0 + o * 8 + i) * PCOLS]);
#pragma unroll
            for (int i = 0; i < 8; ++i) { const float v = w0 * r0 + w1 * r1 + w2 * r2 + w3 * raw[i] + cb; ov[i] = siluf(v); r0 = r1; r1 = r2; r2 = raw[i]; }
            unsigned pk[4];
#pragma unroll
            for (int i = 0; i < 4; ++i) pk[i] = pk2(ov[2 * i], ov[2 * i + 1]);
            const int l = l0 + o * 8;
            *(LAS u32x4*)(XT + cc * LD1 + l) = (u32x4){pk[0], pk[1], pk[2], pk[3]};
#pragma unroll
            for (int i = 0; i < 8; ++i) xs[(size_t)(t0 + l + i) * 1024 + ch] = (bf16)((i & 1) ? (pk[i >> 1] >> 16) : (pk[i >> 1] & 0xffffu));
        }
    }
    __syncthreads();
    const int lrow = wave * 16 + fr;
#pragma unroll 1
    for (int r = 0; r < 4; ++r) {
        const int h = g * 4 + r;
        const float al = acss[r * 128 + lrow];
        LAS bf16* grow = Gs + lrow * LD1;
#pragma unroll
        for (int n = 0; n < 8; ++n) {
            const int s0 = n * 16 + 4 * fq;
            const f32x4 as = *(const LAS f32x4*)(acss + r * 128 + s0), ds = *(const LAS f32x4*)(dts + r * 128 + s0);
            float gv[4];
#pragma unroll
            for (int j = 0; j < 4; ++j) { const float df = fminf(al - as[j], 0.f); gv[j] = (s0 + j <= lrow) ? cbv[0][n][j] * __expf(df) * ds[j] : 0.f; }
            *(LAS u32x2*)(grow + s0) = (u32x2){pk2(gv[0], gv[1]), pk2(gv[2], gv[3])};
        }
        LDS_WAIT(); __builtin_amdgcn_wave_barrier();
        f32x4 yd[1][4];
#pragma unroll
        for (int n = 0; n < 4; ++n) yd[0][n] = (f32x4){0.f, 0.f, 0.f, 0.f};
        wave_mma<1, 4>(yd, Gs + wave * 16 * LD1, LD1, XT + r * 64 * LD1, LD1, 128, lane);
        bf16* ydg = (bf16*)(ws + WS_YDIAG) + (size_t)(t0 + lrow) * 1024 + h * 64;
#pragma unroll
        for (int n = 0; n < 4; ++n) *(u32x2*)(ydg + n * 16 + 4 * fq) = (u32x2){pk2(yd[0][n][0], yd[0][n][1]), pk2(yd[0][n][2], yd[0][n][3])};
        f32x4 st[4];
#pragma unroll
        for (int n = 0; n < 4; ++n) st[n] = (f32x4){0.f, 0.f, 0.f, 0.f};
        const LAS bf16* xa = XT + (r * 64 + (wave & 3) * 16 + fr) * LD1;
        const LAS bf16* bt = BmT + ((wave >> 2) * 64 + fr) * LD1;
#pragma unroll
        for (int k0 = 0; k0 < 128; k0 += 32) {
            const u32x4 xr = *(const LAS u32x4*)(xa + k0 + fq * 8);
            const f32x4 wa = *(const LAS f32x4*)(wls + r * 128 + k0 + fq * 8), wb = *(const LAS f32x4*)(wls + r * 128 + k0 + fq * 8 + 4);
            u32x4 xsq; xsq.x = pk2(bflo(xr.x) * wa[0], bfhi(xr.x) * wa[1]); xsq.y = pk2(bflo(xr.y) * wa[2], bfhi(xr.y) * wa[3]);
            xsq.z = pk2(bflo(xr.z) * wb[0], bfhi(xr.z) * wb[1]); xsq.w = pk2(bflo(xr.w) * wb[2], bfhi(xr.w) * wb[3]);
            const bf16x8 af = __builtin_bit_cast(bf16x8, xsq);
#pragma unroll
            for (int n = 0; n < 4; ++n) { const bf16x8 bfv = *(const LAS bf16x8*)(bt + n * 16 * LD1 + k0 + fq * 8); st[n] = __builtin_amdgcn_mfma_f32_16x16x32_bf16(bfv, af, st[n], 0, 0, 0); }
        }
        bf16* sg = (bf16*)(ws + WS_STATES) + ((size_t)((b * NCH + c) * 16 + h)) * 8192 + ((wave & 3) * 16 + fr) * 128 + (wave >> 2) * 64;
#pragma unroll
        for (int n = 0; n < 4; ++n) *(u32x2*)(sg + n * 16 + 4 * fq) = (u32x2){pk2(st[n][0], st[n][1]), pk2(st[n][2], st[n][3])};
        __builtin_amdgcn_wave_barrier();
    }
    __syncthreads();
}

constexpr int LD2 = 264;
__device__ __forceinline__ void pool_unit(const Args& a, LAS unsigned char* lds, int unit, int tid, int lane, int wave) {
    unsigned char* ws = a.ws;
    const int g = unit & 3, tt = unit >> 2;
    const int t0 = tt * 128, s0 = t0 & (SEQ - 1);
    const int w = 2 << g;
    const bf16* P = (const bf16*)(ws + WS_P);
    LAS bf16* U = (LAS bf16*)lds;
    LAS bf16* Ap = (LAS bf16*)(lds + 75504);
    LAS bf16* Bt = (LAS bf16*)lds;
    for (int i = tid; i < 143 * 32; i += NTHREADS) { const int r = i >> 5, cv = i & 31; const int s = s0 - 15 + r;
        u32x4 v = (u32x4){0u, 0u, 0u, 0u};
        if (s >= 0) v = *(const u32x4*)(P + (size_t)(t0 - 15 + r) * PCOLS + 3072 + g * 256 + cv * 8);
        *(LAS u32x4*)(U + r * LD2 + cv * 8) = v; }
    __syncthreads();
    {
        const int cc = tid & 255, l0 = (tid >> 8) * 64;
        float sum = 0.f;
        for (int j = 1; j < w; ++j) sum += bf2f(U[(15 + l0 - j) * LD2 + cc]);
        for (int l = l0; l < l0 + 64; ++l) {
            const float ucur = bf2f(U[(15 + l) * LD2 + cc]);
            sum += ucur;
            const int s = s0 + l; const float cntw = (float)((s + 1 < w) ? s + 1 : w);
            Ap[l * LD2 + cc] = (bf16)f2bf(sum / cntw - ucur);
            sum -= bf2f(U[(15 + l - w + 1) * LD2 + cc]);
        }
    }
    __syncthreads();
    const bf16* pw = (const bf16*)(ws + WS_PW) + (size_t)g * 256 * 256;
    const float* pscale = a.in[I_POOL_SCALE];
    bf16* ycat = (bf16*)(ws + WS_YCAT);
    const int fr = lane & 15, fq = lane >> 4;
#pragma unroll 1
    for (int hf = 0; hf < 2; ++hf) {
        tile_g2l(Bt, LD2, pw + (size_t)hf * 128 * 256, 256, 128, 256, tid);
        __syncthreads();
        f32x4 acc[1][8];
#pragma unroll
        for (int n = 0; n < 8; ++n) acc[0][n] = (f32x4){0.f, 0.f, 0.f, 0.f};
        wave_mma<1, 8>(acc, Ap + wave * 16 * LD2, LD2, Bt, LD2, 256, lane);
        bf16* orow = ycat + (size_t)(t0 + wave * 16 + fr) * 2048 + 1024 + g * 256 + hf * 128;
#pragma unroll
        for (int n = 0; n < 8; ++n) { const int d = n * 16 + 4 * fq; const f32x4 sc = *(const f32x4*)(pscale + g * 256 + hf * 128 + d); const f32x4 v = acc[0][n] * sc;
            *(u32x2*)(orow + d) = (u32x2){pk2(v[0], v[1]), pk2(v[2], v[3])}; }
        __syncthreads();
    }
}

__device__ __forceinline__ void ssd_combine_unit(const Args& a, LAS unsigned char* lds, int unit, int tid, int lane, int wave) {
    unsigned char* ws = a.ws;
    const int g = unit & 3, c = (unit >> 2) & 31, b = unit >> 7;
    const int t0 = b * SEQ + c * CHUNK;
    LAS bf16* Cm = (LAS bf16*)lds;
    LAS bf16* Pv = (LAS bf16*)(lds + 34816);
    tile_g2l(Cm, LD1, (const bf16*)(ws + WS_CMG) + (size_t)t0 * 512 + g * 128, 512, 128, 128, tid);
    tile_g2l(Pv, LD1, (const bf16*)(ws + WS_PREV) + ((size_t)((b * NCH + c) * 16 + g * 4)) * 8192, 128, 256, 128, tid);
    __syncthreads();
    const int fr = lane & 15, fq = lane >> 4;
    const int t = t0 + wave * 16 + fr;
    const bf16* P = (const bf16*)(ws + WS_P);
    const bf16* ydg = (const bf16*)(ws + WS_YDIAG) + (size_t)t * 1024;
    const bf16* xs = (const bf16*)(ws + WS_XS) + (size_t)t * 1024;
    const float* acsg = (const float*)(ws + WS_ACS) + (size_t)t * 16;
    f32x4 y[4][4]; float ss = 0.f;
#pragma unroll
    for (int r = 0; r < 4; ++r) {
        const int h = g * 4 + r;
        f32x4 yo[1][4];
#pragma unroll
        for (int n = 0; n < 4; ++n) yo[0][n] = (f32x4){0.f, 0.f, 0.f, 0.f};
        wave_mma<1, 4>(yo, Cm + wave * 16 * LD1, LD1, Pv + r * 64 * LD1, LD1, 128, lane);
        const float ea = __expf(acsg[h]), dsk = a.in[I_D_SKIP][h];
#pragma unroll
        for (int n = 0; n < 4; ++n) {
            const int col = h * 64 + n * 16 + 4 * fq;
            const u32x2 ydv = *(const u32x2*)(ydg + col); const f32x4 yd = (f32x4){bflo(ydv.x), bfhi(ydv.x), bflo(ydv.y), bfhi(ydv.y)};
            const u32x2 xv = *(const u32x2*)(xs + col), zv = *(const u32x2*)(P + (size_t)t * PCOLS + col);
            const float xf[4] = {bflo(xv.x), bfhi(xv.x), bflo(xv.y), bfhi(xv.y)}, zf[4] = {bflo(zv.x), bfhi(zv.x), bflo(zv.y), bfhi(zv.y)};
#pragma unroll
            for (int j = 0; j < 4; ++j) { const float v = (yd[j] + yo[0][n][j] * ea + dsk * xf[j]) * siluf(zf[j]); y[r][n][j] = v; ss += v * v; }
        }
    }
    ss += __shfl_xor(ss, 16); ss += __shfl_xor(ss, 32);
    const float rstd = rsqrtf(ss * (1.f / 256.f) + EPS);
    const float* nw = a.in[I_SSD_NORM] + g * 256;
    bf16* orow = (bf16*)(ws + WS_YCAT) + (size_t)t * 2048 + g * 256;
#pragma unroll
    for (int r = 0; r < 4; ++r)
#pragma unroll
        for (int n = 0; n < 4; ++n) { const int col = r * 64 + n * 16 + 4 * fq; const f32x4 w4 = *(const f32x4*)(nw + col); const f32x4 v = y[r][n] * rstd * w4;
            *(u32x2*)(orow + col) = (u32x2){pk2(v[0], v[1]), pk2(v[2], v[3])}; }
    __syncthreads();
}

__device__ __forceinline__ void attn_unit(const Args& a, LAS unsigned char* lds, int unit, int tid, int lane, int wave) {
    unsigned char* ws = a.ws;
    const int h = unit & 3, qt = (unit >> 2) & 31, b = unit >> 7;
    const int t0 = b * SEQ + qt * 128;
    const bf16* q = (const bf16*)(ws + WS_Q); const bf16* km = (const bf16*)(ws + WS_KMEM); const bf16* vt = (const bf16*)(ws + WS_VT);
    LAS bf16* Qc = (LAS bf16*)lds;
    LAS bf16* Kc = (LAS bf16*)(lds + 34816);
    LAS bf16* Ps = (LAS bf16*)lds;
    LAS bf16* Vc = (LAS bf16*)(lds + 67584);
    const int fr = lane & 15, fq = lane >> 4;
    f32x4 s[1][16];
#pragma unroll
    for (int n = 0; n < 16; ++n) s[0][n] = (f32x4){0.f, 0.f, 0.f, 0.f};
#pragma unroll 1
    for (int dc = 0; dc < 4; ++dc) {
        tile_g2l(Qc, LD1, q + (size_t)t0 * 2048 + h * 512 + dc * 128, 2048, 128, 128, tid);
        tile_g2l(Kc, LD1, km + (size_t)(b * NMEM) * 2048 + h * 512 + dc * 128, 2048, 256, 128, tid);
        __syncthreads();
        wave_mma<1, 16>(s, Qc + wave * 16 * LD1, LD1, Kc, LD1, 128, lane);
        __syncthreads();
    }
    float mx = -3.0e38f;
#pragma unroll
    for (int n = 0; n < 16; ++n)
#pragma unroll
        for (int j = 0; j < 4; ++j) mx = fmaxf(mx, s[0][n][j]);
    mx = fmaxf(mx, __shfl_xor(mx, 16)); mx = fmaxf(mx, __shfl_xor(mx, 32));
    float sum = 0.f;
#pragma unroll
    for (int n = 0; n < 16; ++n)
#pragma unroll
        for (int j = 0; j < 4; ++j) { const float e = __expf(s[0][n][j] - mx); s[0][n][j] = e; sum += e; }
    sum += __shfl_xor(sum, 16); sum += __shfl_xor(sum, 32);
    const float inv = 1.0f / sum;
    LAS bf16* prow = Ps + (wave * 16 + fr) * LD2;
#pragma unroll
    for (int n = 0; n < 16; ++n) { const f32x4 p = s[0][n] * inv; *(LAS u32x2*)(prow + n * 16 + 4 * fq) = (u32x2){pk2(p[0], p[1]), pk2(p[2], p[3])}; }
    unsigned char* orow = ws + WS_O + (size_t)(t0 + wave * 16 + fr) * 2048 + h * 512;
#pragma unroll 1
    for (int dc = 0; dc < 4; ++dc) {
        tile_g2l(Vc, LD2, vt + (size_t)(h * 512 + dc * 128) * 512 + b * NMEM, 512, 128, 256, tid);
        __syncthreads();
        f32x4 o[1][8];
#pragma unroll
        for (int n = 0; n < 8; ++n) o[0][n] = (f32x4){0.f, 0.f, 0.f, 0.f};
        wave_mma<1, 8>(o, Ps + wave * 16 * LD2, LD2, Vc, LD2, 256, lane);
#pragma unroll
        for (int n = 0; n < 8; ++n) *(unsigned*)(orow + dc * 128 + n * 16 + 4 * fq) = pk4_fp8(o[0][n][0] * 16.0f, o[0][n][1] * 16.0f, o[0][n][2] * 16.0f, o[0][n][3] * 16.0f);
        __syncthreads();
    }
}

__device__ __forceinline__ void router_phase(const Args& a, LAS unsigned char* lds, int tid, int lane, int wave, int vcu, int G) {
    unsigned char* ws = a.ws;
    LAS bf16* wr = (LAS bf16*)lds;
    LAS int* pick_e = (LAS int*)(lds + 131072);
    LAS float* pick_g = (LAS float*)(lds + 131072 + 512);
    LAS int* pick_lp = (LAS int*)(lds + 131072 + 1024);
    LAS int* lcnt = (LAS int*)(lds + 131072 + 1536);
    LAS int* lbase = lcnt + 32;
    { const u32x4* src = (const u32x4*)(ws + WS_WR); for (int i = tid; i < 32 * 2048 / 8; i += NTHREADS) ((LAS u32x4*)wr)[i] = src[i]; }
    const bf16* h2 = (const bf16*)(ws + WS_H2); const float* nw = a.in[I_NORM_FFN]; const float* brt = a.in[I_B_ROUTER];
    bf16* hn = (bf16*)(ws + WS_HN);
    unsigned* ctl = (unsigned*)(ws + WS_CTL);
    int* tok_of = (int*)(ws + WS_TOK); int* rec_e = (int*)(ws + WS_REC); int* rec_p = rec_e + T * 4; float* rec_g = (float*)(rec_p + T * 4);
    for (int base = vcu * 32; base < T; base += G * 32) {
        if (tid < 32) lcnt[tid] = 0;
        __syncthreads();
#pragma unroll 1
        for (int i = 0; i < 4; ++i) {
            const int lr = wave * 4 + i, m = base + lr;
            const bf16* xr = h2 + (size_t)m * D;
            f32x4 v[8]; float ss = 0.f;
#pragma unroll
            for (int j = 0; j < 8; ++j) { v[j] = ld_row4(xr, lane, j); ss += (v[j].x * v[j].x + v[j].y * v[j].y) + (v[j].z * v[j].z + v[j].w * v[j].w); }
            const float rstd = rsqrtf(wave_sum(ss) * (1.f / D) + EPS);
            unsigned* o4 = (unsigned*)((unsigned char*)hn + (size_t)m * D) + lane;
#pragma unroll
            for (int j = 0; j < 8; ++j) { const f32x4 w4 = ((const f32x4*)nw)[lane + 64 * j]; v[j] = v[j] * rstd * w4; o4[64 * j] = pk4_fp8(v[j].x, v[j].y, v[j].z, v[j].w); }
            float pe[NE];
#pragma unroll
            for (int e = 0; e < NE; ++e) {
                const LAS u32x2* wrow = (const LAS u32x2*)(wr + e * 2048) + lane; float p = 0.f;
#pragma unroll
                for (int j = 0; j < 8; ++j) { const u32x2 w2 = wrow[64 * j]; p += (v[j].x * bflo(w2.x) + v[j].y * bfhi(w2.x)) + (v[j].z * bflo(w2.y) + v[j].w * bfhi(w2.y)); }
                pe[e] = p;
            }
            float w16[16], w8[8], w4[4], w2r[2], w1;
            { const bool bb = (lane & 32) != 0;
#pragma unroll
              for (int i = 0; i < 16; ++i) { const float keep = bb ? pe[16 + i] : pe[i], send = bb ? pe[i] : pe[16 + i]; w16[i] = keep + __shfl_xor(send, 32); } }
            { const bool bb = (lane & 16) != 0;
#pragma unroll
              for (int i = 0; i < 8; ++i) { const float keep = bb ? w16[8 + i] : w16[i], send = bb ? w16[i] : w16[8 + i]; w8[i] = keep + __shfl_xor(send, 16); } }
            { const bool bb = (lane & 8) != 0;
#pragma unroll
              for (int i = 0; i < 4; ++i) { const float keep = bb ? w8[4 + i] : w8[i], send = bb ? w8[i] : w8[4 + i]; w4[i] = keep + __shfl_xor(send, 8); } }
            { const bool bb = (lane & 4) != 0;
#pragma unroll
              for (int i = 0; i < 2; ++i) { const float keep = bb ? w4[2 + i] : w4[i], send = bb ? w4[i] : w4[2 + i]; w2r[i] = keep + __shfl_xor(send, 4); } }
            { const bool bb = (lane & 2) != 0; const float keep = bb ? w2r[1] : w2r[0], send = bb ? w2r[0] : w2r[1]; w1 = keep + __shfl_xor(send, 2); }
            w1 += __shfl_xor(w1, 1);
            const int myexp = lane >> 1;
            float lg = (lane & 1) ? -3.0e38f : w1 + brt[myexp];
            float tv[4]; int ti[4];
#pragma unroll
            for (int k = 0; k < 4; ++k) {
                float bv = lg; int bi = myexp;
#pragma unroll
                for (int o = 1; o < 64; o <<= 1) { const float ov = __shfl_xor(bv, o); const int oi = __shfl_xor(bi, o); if (ov > bv || (ov == bv && oi < bi)) { bv = ov; bi = oi; } }
                tv[k] = bv; ti[k] = bi; if (myexp == bi) lg = -3.0e38f;
            }
            const float e1 = __expf(tv[1] - tv[0]), e2 = __expf(tv[2] - tv[0]), e3 = __expf(tv[3] - tv[0]); const float inv = 1.0f / (1.0f + e1 + e2 + e3);
            if (lane < 4) { const int ee = lane == 0 ? ti[0] : lane == 1 ? ti[1] : lane == 2 ? ti[2] : ti[3]; const float gg = (lane == 0 ? 1.0f : lane == 1 ? e1 : lane == 2 ? e2 : e3) * inv;
                pick_e[lr * 4 + lane] = ee; pick_g[lr * 4 + lane] = gg; }
        }
        __syncthreads();
        if (tid < 128) pick_lp[tid] = atomicAdd((int*)&lcnt[pick_e[tid]], 1);
        __syncthreads();
        if (tid < 32) { const int n = lcnt[tid]; lbase[tid] = n ? (int)__hip_atomic_fetch_add(ctl + CW_CNT + 64 * tid, (unsigned)n, __ATOMIC_RELAXED, __HIP_MEMORY_SCOPE_AGENT) : 0; }
        __syncthreads();
        if (tid < 128) { const int e = pick_e[tid], pos = lbase[e] + pick_lp[tid], m = base + (tid >> 2);
            tok_of[e * 8192 + pos] = m; rec_e[m * 4 + (tid & 3)] = e; rec_p[m * 4 + (tid & 3)] = pos; rec_g[m * 4 + (tid & 3)] = pick_g[tid]; }
        __syncthreads();
    }
}

__device__ __forceinline__ void moe_tile_starts(const unsigned* ctl, LAS int* ts, int tid) {
    if (tid < 64) {
        const int c = (tid < NE) ? (int)__hip_atomic_load(ctl + CW_CNT + 64 * tid, __ATOMIC_RELAXED, __HIP_MEMORY_SCOPE_AGENT) : 0;
        const int nt = (c + 255) >> 8; int s = nt;
#pragma unroll
        for (int o = 1; o < 64; o <<= 1) { const int t = __shfl_up(s, o); if (tid >= o) s += t; }
        if (tid < NE) ts[tid] = s - nt;
        if (tid == NE - 1) ts[NE] = s;
    }
    __syncthreads();
}


__device__ __forceinline__ void final_phase(const Args& a, LAS unsigned char* lds, int tid, int lane, int wave, int vcu, int G) {
    unsigned char* ws = a.ws;
    LAS int* ts = (LAS int*)lds;
    moe_tile_starts((const unsigned*)(ws + WS_CTL), ts, tid);
#ifndef FINAL_MODE
#define FINAL_MODE 0
#endif
    const bf16* h2 = (const bf16*)(ws + WS_H2); const float* nw = a.in[I_NORM_FINAL]; const bf16* y = (const bf16*)(ws + WS_Y);
    const int* rec_e = (const int*)(ws + WS_REC); const int* rec_p = rec_e + T * 4; const float* rec_g = (const float*)(rec_p + T * 4);
    const float* bd = a.in[I_B_DOWN];
    const int gw = vcu * NWAVES + wave, NGW = G * NWAVES;
    f32x4 wv[8];
#pragma unroll
    for (int j = 0; j < 8; ++j) wv[j] = ((const f32x4*)nw)[lane + 64 * j];
    for (int m = gw; m < T; m += NGW) {
        const bf16* xr = h2 + (size_t)m * D;
        f32x4 v[8];
#pragma unroll
        for (int j = 0; j < 8; ++j) v[j] = ld_row4(xr, lane, j);
#pragma unroll 1
        for (int k = 0; k < (FINAL_MODE ? 0 : 4); ++k) {
            const int e = rec_e[m * 4 + k], pos = rec_p[m * 4 + k]; const float gt = rec_g[m * 4 + k];
            const int slot = ts[e] * 256 + pos;
            const u32x2* yr = (const u32x2*)(y + (size_t)slot * 2048) + lane;
#pragma unroll
            for (int j = 0; j < 8; ++j) { const u32x2 w2 = yr[64 * j]; v[j].x += gt * bflo(w2.x); v[j].y += gt * bfhi(w2.x); v[j].z += gt * bflo(w2.y); v[j].w += gt * bfhi(w2.y); }
        }
        float ss = 0.f;
#pragma unroll
        for (int j = 0; j < 8; ++j) ss += (v[j].x * v[j].x + v[j].y * v[j].y) + (v[j].z * v[j].z + v[j].w * v[j].w);
        const float rstd = rsqrtf(wave_sum(ss) * (1.f / D) + EPS);
        f32x4* o = (f32x4*)(a.out + (size_t)m * D) + lane;
#pragma unroll
        for (int j = 0; j < 8; ++j) { f32x4 r = v[j] * rstd * wv[j];
#ifdef SANITIZE
            for (int q = 0; q < 4; ++q) if (!(fabsf(r[q]) < 1e30f)) r[q] = 0.f;
#endif
            o[64 * j] = r; }
    }
    (void)bd;
}

__global__ void __launch_bounds__(NTHREADS, 2) hybrid_fwd(Args args) {
    extern __shared__ __attribute__((aligned(16))) unsigned char lds_raw[];
    LAS unsigned char* lds = (LAS unsigned char*)lds_raw;
    volatile LAS unsigned* MISC = (volatile LAS unsigned*)(lds + MISC_OFF);
    const int tid = threadIdx.x, lane = tid & 63, wave = __builtin_amdgcn_readfirstlane(tid >> 6);
    const int G = gridDim.x; const int bx = blockIdx.x; const int vcu = (G % 8 == 0) ? (bx % 8) * (G / 8) + bx / 8 : bx;
    unsigned char* ws = args.ws;
    unsigned* ctl = (unsigned*)(ws + WS_CTL);
    for (int u = tid; u < (LDS_BYTES - MISC_OFF) / 4; u += NTHREADS) ((LAS unsigned*)(lds + MISC_OFF))[u] = 0u;
    __syncthreads();
    XcdBarrier bar; bar.bar = ctl + CW_BAR; bar.x = 0; bar.st = nullptr;
    if (MK_LAUNCHES == 1) bar = xcd_barrier_post(ctl + CW_BAR, MISC + 8);
    const int lo = args.ph_lo, hi = args.ph_hi;
#ifndef PHASE_MASK
#define PHASE_MASK 0x3fff
#endif
#define IN(k) ((((PHASE_MASK) >> (k)) & 1) && lo <= (k) && (k) < hi)
#define SEAM(k) do { if (IN(k) && IN((k) + 1)) xcd_barrier(bar); } while (0)
#define REP_BEGIN(k) {
#define REP_END(k) }

    if (IN(0)) { REP_BEGIN(0) p0_prologue(args, lds, tid, lane, wave, vcu, G); REP_END(0) SEAM(0); }

    if (IN(1)) {
        { DenseSched S{(const char*)(ws + WS_HN), (const char*)(ws + WS_WIN), (char*)(ws + WS_P), PCOLS, 32, 16, 512, G, bx};
          pg8::EpiBf16P<0> E;
          pg8::gemm_phase<pg8::EpiBf16P<0>, DenseSched, false>(lds, S, E); }
        { KvSched S{(const char*)(ws + WS_MEMN), (const char*)(ws + WS_WK), (const char*)(ws + WS_WV), (char*)(ws + WS_KMEM), (char*)(ws + WS_VT), G, bx};
          pg8::EpiBf16P<0> E;
          pg8::gemm_phase<pg8::EpiBf16P<0>, KvSched, false, true>(lds, S, E); }
        SEAM(1);
    }
    if (IN(2)) {
        REP_BEGIN(2)
        for (int u = vcu; u < 256; u += G) ssd_chunk_unit(args, lds, u, tid, lane, wave);
        for (int u = vcu; u < 256; u += G) pool_unit(args, lds, u, tid, lane, wave);
        REP_END(2)
        SEAM(2);
    }
    if (IN(3)) {
        REP_BEGIN(3)
        const bf16* st = (const bf16*)(ws + WS_STATES); const float* cdec = (const float*)(ws + WS_CDEC); bf16* prev = (bf16*)(ws + WS_PREV);
        for (int idx = bx * NTHREADS + tid; idx < NB * 16 * 4096; idx += G * NTHREADS) {
            const int b = idx >> 16, rem = idx & 65535, h = rem >> 12, e2 = rem & 4095;
            float h0 = 0.f, h1 = 0.f;
#pragma unroll 4
            for (int c = 0; c < NCH; ++c) {
                const size_t o = ((size_t)((b * NCH + c) * 16 + h)) * 8192 + e2 * 2;
                const unsigned sw = *(const unsigned*)(st + o); const f32x2 s = (f32x2){bflo(sw), bfhi(sw)}; const float dc = cdec[(b * NCH + c) * 16 + h];
                *(unsigned*)(prev + o) = pk2(h0, h1);
                h0 = h0 * dc + s.x; h1 = h1 * dc + s.y;
            }
        }
        REP_END(3)
        SEAM(3);
    }
    if (IN(4)) { REP_BEGIN(4) for (int u = vcu; u < 256; u += G) ssd_combine_unit(args, lds, u, tid, lane, wave); REP_END(4) SEAM(4); }
    if (IN(5)) {
        DenseSched S{(const char*)(ws + WS_YCAT), (const char*)(ws + WS_WOUT), nullptr, 2048, 32, 8, 256, G, bx};
        pg8::EpiResBf16<true> E{(const void*)args.in[I_X], (bf16*)(ws + WS_H1), 2048};
        pg8::gemm_phase<pg8::EpiResBf16<true>, DenseSched, false>(lds, S, E);
        SEAM(5);
    }
    if (IN(6)) { rms_rows_bf16((const bf16*)(ws + WS_H1), args.in[I_NORM_XATTN], (bf16*)(ws + WS_HN), T, vcu * NWAVES + wave, G * NWAVES, lane); SEAM(6); }
    if (IN(7)) {
        DenseSched S{(const char*)(ws + WS_HN), (const char*)(ws + WS_WQ), (char*)(ws + WS_Q), 2048, 32, 8, 256, G, bx, 2048};
        pg8::EpiBf16P<1> E;
        pg8::gemm_phase<pg8::EpiBf16P<1>, DenseSched, false, true>(lds, S, E);
        SEAM(7);
    }
    if (IN(8)) { REP_BEGIN(8) for (int u = vcu; u < 256; u += G) attn_unit(args, lds, u, tid, lane, wave); REP_END(8) SEAM(8); }
    if (IN(9)) {
        DenseSched S{(const char*)(ws + WS_O), (const char*)(ws + WS_WO), nullptr, 2048, 32, 8, 256, G, bx, 2048};
        pg8::EpiResBf16<false> E{(const void*)(ws + WS_H1), (bf16*)(ws + WS_H2), 2048};
        pg8::gemm_phase<pg8::EpiResBf16<false>, DenseSched, false, true, 0x7b7b7b7b>(lds, S, E);
        SEAM(9);
    }
    if (IN(10)) { router_phase(args, lds, tid, lane, wave, vcu, G); SEAM(10); }
    if (IN(11)) {
        REP_BEGIN(11)
        LAS int* ts = (LAS int*)(lds + 131072);
        moe_tile_starts(ctl, ts, tid);
        LAS int* tokl = (LAS int*)(lds + 131072 + 256);
        MoeSched S{ts, (const int*)(ctl + CW_CNT), (const int*)(ws + WS_TOK), (const char*)(ws + WS_HN), (const char*)(ws + WS_WGU), (char*)(ws + WS_ACT), 16, 128, G, bx, (size_t)4096 * 2048, true, nullptr, tokl};
        for (int i = 0; i < 15; ++i) { pg8::Unit u; if (!S.next(i, u)) break; if (tid < 256) tokl[i * 256 + tid] = (tid < u.cnt) ? u.tok[tid] : 0; }
        __syncthreads();
        pg8::EpiSwiglu E{args.in[I_B_GATE], args.in[I_B_UP]};
        pg8::gemm_phase<pg8::EpiSwiglu, MoeSched, true, true>(lds, S, E);
        REP_END(11)
        SEAM(11);
    }
    if (IN(12)) {
        REP_BEGIN(12)
        LAS int* ts = (LAS int*)(lds + 131072);
        moe_tile_starts(ctl, ts, tid);
        MoeSched S{ts, (const int*)(ctl + CW_CNT), (const int*)(ws + WS_TOK), (const char*)(ws + WS_ACT), (const char*)(ws + WS_WD), (char*)(ws + WS_Y), 8, 256, G, bx, (size_t)2048 * 2048, false, nullptr, nullptr};
        pg8::EpiBf16B E{args.in[I_B_DOWN], 2048};
        pg8::gemm_phase<pg8::EpiBf16B, MoeSched, false, true>(lds, S, E);
        REP_END(12)
        SEAM(12);
    }
#ifdef DIAG
    if (lo <= 13 && 13 < hi) {
        unsigned flags = 0;
        const size_t gt = (size_t)bx * NTHREADS + tid, gn = (size_t)G * NTHREADS;
    }
    if (lo <= 14 && 14 < hi) {
        for (size_t i = (size_t)bx * NTHREADS + tid; i < (size_t)T * D; i += (size_t)G * NTHREADS) args.out[i] = 0.f;
        if (bx == 0 && tid == 0) args.out[0] = 1000.0f * (float)ctl[10];
    }
#else
    if (IN(13)) { final_phase(args, lds, tid, lane, wave, vcu, G); }
#endif
#undef IN
#undef SEAM
}

extern "C" void kernel_launch(void* const* d_in, const int* in_sizes, int n_in, void* d_out, int out_size, void* d_ws, size_t ws_size, hipStream_t stream) {
    static int grid = 0;
    if (grid == 0) {
        if (n_in != 28 || out_size != T * D || ws_size < WS_END) { fprintf(stderr, "kernel_launch: unexpected shapes (n_in %d, out %d, ws %zu < %zu)\n", n_in, out_size, ws_size, (size_t)WS_END); grid = -1; return; }
        int dev = 0, cus = 0, per_cu = 0;
        if (hipGetDevice(&dev) != hipSuccess || hipDeviceGetAttribute(&cus, hipDeviceAttributeMultiprocessorCount, dev) != hipSuccess) { grid = -1; return; }
        if (hipFuncSetAttribute((const void*)hybrid_fwd, hipFuncAttributeMaxDynamicSharedMemorySize, LDS_BYTES) != hipSuccess) { fprintf(stderr, "kernel_launch: hipFuncSetAttribute failed\n"); grid = -1; return; }
        if (hipOccupancyMaxActiveBlocksPerMultiprocessor(&per_cu, (const void*)hybrid_fwd, NTHREADS, LDS_BYTES) != hipSuccess || per_cu < 1)
            fprintf(stderr, "kernel_launch: occupancy query reports %d workgroups per CU\n", per_cu);
        (void)hipGetLastError();
        grid = cus;
    }
    if (grid < 0) return;
    if (hipMemsetAsync((char*)d_ws + WS_CTL, 0, CTL_ZERO_BYTES, stream) != hipSuccess) return;
    Args a{};
    for (int i = 0; i < 28; ++i) a.in[i] = (const float*)d_in[i];
    a.out = (float*)d_out; a.ws = (unsigned char*)d_ws; a.pad = 0;
#ifndef DUP_MASK
#define DUP_MASK 0
#endif
    for (int li = 0; li < MK_LAUNCHES; ++li) for (int rep = 0; rep < 1 + ((MK_LAUNCHES > 1) ? ((DUP_MASK >> li) & 1) : 0); ++rep) {
        a.pad = rep;
        if (MK_LAUNCHES > 1 && li == 10) hipMemsetAsync((char*)d_ws + WS_CTL + (size_t)CW_CNT * 4, 0, 32 * 64 * 4, stream);
        a.ph_lo = (MK_LAUNCHES == 1) ? 0 : li; a.ph_hi = (MK_LAUNCHES == 1) ? NPHASE + 1 : li + 1; a.li = li;
        hipLaunchKernelGGL(hybrid_fwd, dim3(grid), dim3(NTHREADS), LDS_BYTES, stream, a);
        const hipError_t le = hipPeekAtLastError();
        if (le != hipSuccess) { fprintf(stderr, "kernel_launch: launch %d failed: %s\n", li, hipGetErrorName(le)); break; }
    }
}
```
